# Optimizing an MI355X kernel written in HIP

```python
import jax
import jax.numpy as jnp
from jax import lax
import numpy as np

D_MODEL = 1024
BATCH = 8
SEQ = 2048
DEPTH = 1
DEC_BATCH = 16
DEC_SEQ = 32
PAST_LEN = 1024

CHUNK = 64
A_HEADS = 8
A_HEAD_DIM = 64
A_WIDTH = A_HEADS * A_HEAD_DIM
BAND_CHUNKS = 8
MAX_REL = 128
B_HEADS = 4
B_HEAD_DIM = 128
B_WIDTH = B_HEADS * B_HEAD_DIM
CONV_W = 4
IN_WIDTH = 3 * A_WIDTH + 4 * B_WIDTH + 2 * B_HEADS + 2 * D_MODEL
MEM_TOKENS = 256
X_HEADS = 4
X_HEAD_DIM = D_MODEL // X_HEADS
PEER_HEADS = 8
N_KEYS = 128
N_EXPERTS = N_KEYS * N_KEYS
PEER_TOPK = 16
PEER_QDIM = 256
PEER_HALF = PEER_QDIM // 2
PEER_BLOCK = 128
EPS = 1e-6

kernel_name = 'hybrid_streaming_encoder_step'


def rms_norm(x, g):
    xf = x.astype(jnp.float32)
    r = lax.rsqrt(jnp.mean(xf * xf, axis=-1, keepdims=True) + EPS)
    return (xf * r).astype(x.dtype) * g.astype(x.dtype)


def _split_in(z):
    sizes = [A_WIDTH] * 3 + [B_WIDTH] * 4 + [2 * B_HEADS, D_MODEL, D_MODEL]
    bounds = [int(b) for b in np.cumsum(sizes)[:-1]]
    return jnp.split(z, bounds, axis=-1)


def _rel_bias(rel_bias, q_pos, k_pos):
    rel = jnp.clip(q_pos[..., :, None] - k_pos[..., None, :], -MAX_REL, MAX_REL) + MAX_REL
    return rel_bias[:, rel].astype(jnp.float32)


def band_attention_prompt(q, k, v, rel_bias):
    bsz, t, h, dh = q.shape
    nc = t // CHUNK
    width = (BAND_CHUNKS + 1) * CHUNK
    pad = BAND_CHUNKS * CHUNK
    kp = jnp.pad(k, ((0, 0), (pad, 0), (0, 0), (0, 0)))
    vp = jnp.pad(v, ((0, 0), (pad, 0), (0, 0), (0, 0)))
    band = jnp.arange(nc)[:, None] * CHUNK + jnp.arange(width)[None, :]
    kb = kp[:, band]
    vb = vp[:, band]
    q_pos = jnp.arange(nc)[:, None] * CHUNK + jnp.arange(CHUNK)[None, :]
    k_pos = band - pad
    s = jnp.einsum('bcqhd,bckhd->bhcqk', q.reshape(bsz, nc, CHUNK, h, dh), kb).astype(jnp.float32)
    s = s * (dh ** -0.5) + _rel_bias(rel_bias, q_pos, k_pos)[None]
    s = jnp.where((k_pos >= 0)[None, None, :, None, :], s, -jnp.inf)
    p = jax.nn.softmax(s, axis=-1).astype(v.dtype)
    o = jnp.einsum('bhcqk,bckhd->bcqhd', p, vb)
    return o.reshape(bsz, t, h * dh)


def band_attention_cached(q, k, v, k_prev, v_prev, rel_bias):
    bsz, s_len, h, dh = q.shape
    past = k_prev.shape[1]
    kk = jnp.concatenate([k_prev, k], axis=1)
    vv = jnp.concatenate([v_prev, v], axis=1)
    q_pos = past + jnp.arange(s_len)
    k_pos = jnp.arange(past + s_len)
    s = jnp.einsum('bqhd,bkhd->bhqk', q, kk).astype(jnp.float32)
    s = s * (dh ** -0.5) + _rel_bias(rel_bias, q_pos, k_pos)[None]
    p = jax.nn.softmax(s, axis=-1).astype(v.dtype)
    o = jnp.einsum('bhqk,bkhd->bqhd', p, vv)
    return o.reshape(bsz, s_len, h * dh)


def causal_conv(u, prev, w, b):
    t = u.shape[1]
    up = jnp.concatenate([prev, u], axis=1)
    out = b + sum(up[:, j:j + t] * w[j] for j in range(CONV_W))
    return out, up[:, up.shape[1] - (CONV_W - 1):]


def mlstm_chunk(C0, n0, m0, q, k, v, ig, lf):
    L = q.shape[1]
    b = jnp.cumsum(lf, axis=1)
    dm = b[:, :, None, :] - b[:, None, :, :] + ig[:, None, :, :]
    causal = jnp.tril(jnp.ones((L, L), dtype=bool))
    dm = jnp.where(causal[None, :, :, None], dm, -jnp.inf)
    inter = b + m0[:, None, :]
    m = jnp.maximum(dm.max(axis=2), inter)
    w_intra = jnp.exp(dm - m[:, :, None, :])
    w_inter = jnp.exp(inter - m)
    a = jnp.einsum('bthd,bshd->btsh', q, k) * w_intra
    num = jnp.einsum('btsh,bshd->bthd', a, v) + w_inter[..., None] * jnp.einsum('bthk,bhkv->bthv', q, C0)
    den = a.sum(axis=2) + w_inter * jnp.einsum('bthk,bhk->bth', q, n0)
    h = num / jnp.maximum(jnp.abs(den), jnp.exp(-m))[..., None]
    bl = b[:, -1]
    wk = bl[:, None, :] - b + ig
    ml = jnp.maximum(bl + m0, wk.max(axis=1))
    a0 = jnp.exp(bl + m0 - ml)
    ws = jnp.exp(wk - ml[:, None, :])
    C = a0[..., None, None] * C0 + jnp.einsum('bsh,bshk,bshv->bhkv', ws, k, v)
    n = a0[..., None] * n0 + jnp.einsum('bsh,bshk->bhk', ws, k)
    return h, (C, n, ml)


def mlstm_prompt(q, k, v, ig, lf):
    bsz, t, h, d = q.shape
    nc = t // CHUNK

    def to_blocks(a):
        return jnp.moveaxis(a.reshape((bsz, nc, CHUNK) + a.shape[2:]), 1, 0)

    init = (jnp.zeros((bsz, h, d, d), jnp.float32), jnp.zeros((bsz, h, d), jnp.float32),
            jnp.zeros((bsz, h), jnp.float32))

    def step(carry, xs):
        out, carry = mlstm_chunk(*carry, *xs)
        return carry, out

    carry, hs = lax.scan(step, init, (to_blocks(q), to_blocks(k), to_blocks(v), to_blocks(ig), to_blocks(lf)))
    return jnp.moveaxis(hs, 0, 1).reshape(bsz, t, h, d), carry


def memory_kv(mem, g_mem, w_mk, w_mv):
    bsz, m, _ = mem.shape
    mn = rms_norm(mem, g_mem)
    return ((mn @ w_mk).reshape(bsz, m, X_HEADS, X_HEAD_DIM),
            (mn @ w_mv).reshape(bsz, m, X_HEADS, X_HEAD_DIM))


def cross_attention(h, mem_k, mem_v, w_cq, w_co):
    bsz, t, _ = h.shape
    q = (h @ w_cq).reshape(bsz, t, X_HEADS, X_HEAD_DIM)
    s = jnp.einsum('bthd,bmhd->bhtm', q, mem_k).astype(jnp.float32) * (X_HEAD_DIM ** -0.5)
    p = jax.nn.softmax(s, axis=-1).astype(mem_v.dtype)
    o = jnp.einsum('bhtm,bmhd->bthd', p, mem_v).reshape(bsz, t, D_MODEL)
    return o @ w_co


def peer_ffn(h, w_pq, sub_keys, peer_u, peer_v):
    bsz, t, d = h.shape
    xf = h.reshape(bsz * t, d)
    n = xf.shape[0]
    nb = -(-n // PEER_BLOCK)
    xf = jnp.pad(xf, ((0, nb * PEER_BLOCK - n), (0, 0)))

    def block(xb):
        p = xb.shape[0]
        q = (xb @ w_pq).reshape(p, PEER_HEADS, 2, PEER_HALF)
        s = jnp.einsum('phcd,hckd->phck', q, sub_keys)
        sv, si = lax.top_k(s, PEER_TOPK)
        cand = sv[:, :, 0, :, None] + sv[:, :, 1, None, :]
        cidx = si[:, :, 0, :, None] * N_KEYS + si[:, :, 1, None, :]
        cv, ci = lax.top_k(cand.reshape(p, PEER_HEADS, PEER_TOPK * PEER_TOPK), PEER_TOPK)
        eidx = jnp.take_along_axis(cidx.reshape(p, PEER_HEADS, PEER_TOPK * PEER_TOPK), ci, axis=-1)
        g = jax.nn.softmax(cv.astype(jnp.float32), axis=-1).astype(xb.dtype)
        act = jax.nn.gelu(jnp.einsum('phkd,pd->phk', peer_u[eidx], xb), approximate=False)
        return jnp.einsum('phk,phkd->pd', g * act, peer_v[eidx])

    out = lax.map(block, xf.reshape(nb, PEER_BLOCK, d))
    return out.reshape(nb * PEER_BLOCK, d)[:n].reshape(bsz, t, d)


def _layer(x, mem_k, mem_v, a_k_prev, a_v_prev, conv_prev, C0, n0, m0,
           g_mix, w_in, conv_w, conv_b, b_if, g_head, rel_bias, w_a_up, w_b_up, w_out,
           g_cross, w_cq, w_co, g_ffn, w_pq, sub_keys, peer_u, peer_v):
    first = a_k_prev is None
    bsz, t, _ = x.shape
    f32 = jnp.float32
    h = rms_norm(x, g_mix)
    qa, ka, va, qb, kb, vb, ob, if_pre, ga, gb = _split_in(h @ w_in)
    qa = qa.reshape(bsz, t, A_HEADS, A_HEAD_DIM)
    ka = ka.reshape(bsz, t, A_HEADS, A_HEAD_DIM)
    va = va.reshape(bsz, t, A_HEADS, A_HEAD_DIM)
    if first:
        out_a = band_attention_prompt(qa, ka, va, rel_bias)
        keep = min(BAND_CHUNKS * CHUNK, t)
        new_ak, new_av = ka[:, t - keep:], va[:, t - keep:]
        conv_prev = jnp.zeros((bsz, CONV_W - 1, 2 * B_WIDTH), x.dtype)
    else:
        out_a = band_attention_cached(qa, ka, va, a_k_prev, a_v_prev, rel_bias)
        new_ak, new_av = ka, va
    qk_b, new_conv = causal_conv(jnp.concatenate([qb, kb], axis=-1), conv_prev, conv_w, conv_b)
    qb, kb = jnp.split(jax.nn.silu(qk_b), 2, axis=-1)
    qb = qb.reshape(bsz, t, B_HEADS, B_HEAD_DIM).astype(f32)
    kb = kb.reshape(bsz, t, B_HEADS, B_HEAD_DIM).astype(f32) * (B_HEAD_DIM ** -0.5)
    vb = vb.reshape(bsz, t, B_HEADS, B_HEAD_DIM).astype(f32)
    gates = (if_pre + b_if).astype(f32)
    ig = gates[..., :B_HEADS]
    lf = jax.nn.log_sigmoid(gates[..., B_HEADS:])
    if first:
        hb, (C, n, m) = mlstm_prompt(qb, kb, vb, ig, lf)
    else:
        hb, (C, n, m) = mlstm_chunk(C0.astype(f32), n0.astype(f32), m0.astype(f32), qb, kb, vb, ig, lf)
    hb = rms_norm(hb, g_head.reshape(B_HEADS, B_HEAD_DIM).astype(f32)).astype(x.dtype)
    hb = jax.nn.sigmoid(ob) * hb.reshape(bsz, t, B_WIDTH)
    mixed = jax.nn.sigmoid(ga) * (out_a @ w_a_up) + jax.nn.sigmoid(gb) * (hb @ w_b_up)
    x = x + mixed @ w_out
    x = x + cross_attention(rms_norm(x, g_cross), mem_k, mem_v, w_cq, w_co)
    x = x + peer_ffn(rms_norm(x, g_ffn), w_pq, sub_keys, peer_u, peer_v)
    return x, (new_ak, new_av, new_conv, C.astype(x.dtype), n.astype(x.dtype), m.astype(x.dtype))


def setup_inputs(seed: int = 0) -> dict:
    key = jax.random.key(seed)
    ks = iter(jax.random.split(key, 40))
    f32 = jnp.float32

    def nrm(shape, scale):
        return jax.random.normal(next(ks), shape, f32) * scale

    def gain(shape):
        return 1.0 + nrm(shape, 0.02)

    a_cache = min(BAND_CHUNKS * CHUNK, PAST_LEN)
    b_if = jnp.concatenate([nrm((DEPTH, B_HEADS), 0.1),
                            jnp.linspace(3.0, 6.0, B_HEADS, dtype=f32)[None] + nrm((DEPTH, B_HEADS), 0.1)], axis=-1)
    return {
        'x_prompt': nrm((BATCH, SEQ, D_MODEL), 1.0),
        'x_sample': nrm((DEC_BATCH, DEC_SEQ, D_MODEL), 1.0),
        'mem_prompt': nrm((BATCH, MEM_TOKENS, D_MODEL), 1.0),
        'cache_a_k': nrm((DEPTH, DEC_BATCH, a_cache, A_HEADS, A_HEAD_DIM), 1.0),
        'cache_a_v': nrm((DEPTH, DEC_BATCH, a_cache, A_HEADS, A_HEAD_DIM), 1.0),
        'state_b_conv': nrm((DEPTH, DEC_BATCH, CONV_W - 1, 2 * B_WIDTH), 1.0),
        'state_b_C': nrm((DEPTH, DEC_BATCH, B_HEADS, B_HEAD_DIM, B_HEAD_DIM), 0.1),
        'state_b_n': nrm((DEPTH, DEC_BATCH, B_HEADS, B_HEAD_DIM), 0.1),
        'state_b_m': nrm((DEPTH, DEC_BATCH, B_HEADS), 0.5),
        'cache_mem_k': nrm((DEPTH, DEC_BATCH, MEM_TOKENS, X_HEADS, X_HEAD_DIM), 1.0),
        'cache_mem_v': nrm((DEPTH, DEC_BATCH, MEM_TOKENS, X_HEADS, X_HEAD_DIM), 1.0),
        'g_mix': gain((DEPTH, D_MODEL)),
        'w_in': nrm((DEPTH, D_MODEL, IN_WIDTH), D_MODEL ** -0.5),
        'conv_w': nrm((DEPTH, CONV_W, 2 * B_WIDTH), 0.5),
        'conv_b': nrm((DEPTH, 2 * B_WIDTH), 0.02),
        'b_if': b_if,
        'g_head': gain((DEPTH, B_WIDTH)),
        'rel_bias': nrm((DEPTH, A_HEADS, 2 * MAX_REL + 1), 0.1),
        'w_a_up': nrm((DEPTH, A_WIDTH, D_MODEL), A_WIDTH ** -0.5),
        'w_b_up': nrm((DEPTH, B_WIDTH, D_MODEL), B_WIDTH ** -0.5),
        'w_out': nrm((DEPTH, D_MODEL, D_MODEL), D_MODEL ** -0.5),
        'g_mem': gain((DEPTH, D_MODEL)),
        'w_mk': nrm((DEPTH, D_MODEL, D_MODEL), D_MODEL ** -0.5),
        'w_mv': nrm((DEPTH, D_MODEL, D_MODEL), D_MODEL ** -0.5),
        'g_cross': gain((DEPTH, D_MODEL)),
        'w_cq': nrm((DEPTH, D_MODEL, D_MODEL), D_MODEL ** -0.5),
        'w_co': nrm((DEPTH, D_MODEL, D_MODEL), D_MODEL ** -0.5),
        'g_ffn': gain((DEPTH, D_MODEL)),
        'w_pq': nrm((DEPTH, D_MODEL, PEER_HEADS * PEER_QDIM), D_MODEL ** -0.5),
        'sub_keys': nrm((DEPTH, PEER_HEADS, 2, N_KEYS, PEER_HALF), PEER_HALF ** -0.5),
        'peer_u': nrm((DEPTH, N_EXPERTS, D_MODEL), D_MODEL ** -0.5),
        'peer_v': nrm((DEPTH, N_EXPERTS, D_MODEL), 0.1),
        'g_final': gain((D_MODEL,)),
    }


def _stack(states, i):
    return jnp.stack([st[i] for st in states])


def reference(x_prompt, x_sample, mem_prompt, cache_a_k, cache_a_v, state_b_conv, state_b_C, state_b_n,
              state_b_m, cache_mem_k, cache_mem_v, g_mix, w_in, conv_w, conv_b, b_if, g_head, rel_bias,
              w_a_up, w_b_up, w_out, g_mem, w_mk, w_mv, g_cross, w_cq, w_co, g_ffn, w_pq, sub_keys,
              peer_u, peer_v, g_final):
    yp, ys = x_prompt, x_sample
    ps, ss = [], []
    for l in range(DEPTH):
        wl = (g_mix[l], w_in[l], conv_w[l], conv_b[l], b_if[l], g_head[l], rel_bias[l], w_a_up[l], w_b_up[l],
              w_out[l], g_cross[l], w_cq[l], w_co[l], g_ffn[l], w_pq[l], sub_keys[l], peer_u[l], peer_v[l])
        mk_p, mv_p = memory_kv(mem_prompt, g_mem[l], w_mk[l], w_mv[l])
        yp, sp = _layer(yp, mk_p, mv_p, None, None, None, None, None, None, *wl)
        ys, sq = _layer(ys, cache_mem_k[l], cache_mem_v[l], cache_a_k[l], cache_a_v[l], state_b_conv[l],
                        state_b_C[l], state_b_n[l], state_b_m[l], *wl)
        ps.append(sp + (mk_p, mv_p))
        ss.append(sq)
    y_prompt = rms_norm(yp, g_final)
    y_sample = rms_norm(ys, g_final)
    return (y_prompt, y_sample,
            _stack(ps, 0), _stack(ps, 1), _stack(ps, 2), _stack(ps, 3), _stack(ps, 4), _stack(ps, 5),
            _stack(ps, 6), _stack(ps, 7),
            _stack(ss, 0), _stack(ss, 1), _stack(ss, 2), _stack(ss, 3), _stack(ss, 4), _stack(ss, 5))
```

```cpp
#include <hip/hip_runtime.h>
#include <hip/hip_cooperative_groups.h>
#include <cstdio>
#include <cstring>
namespace cg = cooperative_groups;

#ifndef COOP
#define COOP 1
#endif

typedef unsigned short u16;
typedef unsigned int u32;
typedef __attribute__((ext_vector_type(8))) short bf16x8;
typedef __attribute__((ext_vector_type(4))) float f32x4;
#define MFMA(a, b, c) __builtin_amdgcn_mfma_f32_16x16x32_bf16(a, b, c, 0, 0, 0)

constexpr int NT = 16896;
constexpr int NP = 16384;
constexpr int ZLD = 3712;
constexpr int NPHASE = 16;
constexpr int HLD = 1152;
constexpr int WLD5 = 640;
constexpr int PQLD = 2176;
constexpr int VLD = 17024;

constexpr size_t OFF_WT_IN = 0;
constexpr size_t OFF_WT_AUP = OFF_WT_IN + 5760ull * HLD * 2;
constexpr size_t OFF_WT_BUP = OFF_WT_AUP + 1024ull * WLD5 * 2;
constexpr size_t OFF_WT_OUT = OFF_WT_BUP + 1024ull * WLD5 * 2;
constexpr size_t OFF_WT_MKV = OFF_WT_OUT + 1024ull * HLD * 2;
constexpr size_t OFF_WT_CQ = OFF_WT_MKV + 2048ull * HLD * 2;
constexpr size_t OFF_WT_CO = OFF_WT_CQ + 1024ull * HLD * 2;
constexpr size_t OFF_WT_PQ = OFF_WT_CO + 1024ull * HLD * 2;
constexpr size_t OFF_SUBK = OFF_WT_PQ + 2048ull * HLD * 2;
constexpr size_t OFF_CTR = OFF_SUBK + 262144ull * 2;
constexpr size_t OFF_P = OFF_CTR + 4096;
constexpr size_t OFF_PU = OFF_P;
constexpr size_t OFF_PV = OFF_P + 16384ull * 1024;
constexpr size_t OFF_ROUTE = OFF_P + 2ull * 16384 * 1024;
constexpr size_t OFF_KC = OFF_P;
constexpr size_t OFF_VCT = OFF_KC + 16ull * 512 * 512 * 2;
constexpr size_t OFF_VAT = OFF_VCT + 16ull * 512 * 512 * 2;
constexpr size_t OFF_VBT = OFF_VAT + 512ull * VLD * 2;
constexpr size_t OFF_MN = OFF_VBT + 512ull * VLD * 2;
constexpr size_t OFF_H = OFF_P + 2ull * 16384 * 1024 * 2;
constexpr size_t OFF_Z = OFF_H + (size_t)NT * HLD * 2;
constexpr size_t OFF_QC = OFF_Z;
constexpr size_t OFF_PQ = OFF_Z + (size_t)NT * HLD * 2;
constexpr size_t OFF_MK = OFF_Z + (size_t)NT * ZLD * 2;
constexpr size_t OFF_MVT = OFF_MK + 6144ull * HLD * 2;
constexpr size_t OFF_DELTA = OFF_MVT + 6144ull * 1024 * 2;
constexpr size_t OFF_NBUF = OFF_DELTA + 1024ull * 16384 * 2;
constexpr size_t OFF_SCAL = OFF_NBUF + 1024ull * 128 * 4;
constexpr size_t OFF_BAR = OFF_SCAL + 1024ull * 4 * 4;
constexpr size_t WS_END = OFF_BAR + 16384;
static_assert(OFF_MN + 2048ull * HLD * 2 <= OFF_H, "early scratch overflows peer region");
static_assert(OFF_ROUTE + (size_t)NT * 128 * 8 <= OFF_H, "route overflows peer region");
static_assert(OFF_PQ + (size_t)NT * PQLD * 2 <= OFF_MK, "pq overflows z region");
static_assert(WS_END <= 336ull * 1000 * 1000, "workspace budget");

constexpr size_t O_Y = 0;
constexpr size_t O_PAK = (size_t)NT * 1024;
constexpr size_t O_PAV = O_PAK + 2097152;
constexpr size_t O_PBCONV = O_PAV + 2097152;
constexpr size_t O_PBC = O_PBCONV + 24576;
constexpr size_t O_PBN = O_PBC + 524288;
constexpr size_t O_PBM = O_PBN + 4096;
constexpr size_t O_PMK = O_PBM + 32;
constexpr size_t O_PMV = O_PMK + 2097152;
constexpr size_t O_SAK = O_PMV + 2097152;
constexpr size_t O_SAV = O_SAK + 262144;
constexpr size_t O_SBCONV = O_SAV + 262144;
constexpr size_t O_SBC = O_SBCONV + 49152;
constexpr size_t O_SBN = O_SBC + 1048576;
constexpr size_t O_SBM = O_SBN + 8192;

constexpr int SMEM_BYTES = 79872;

struct Params {
  const float *x_prompt, *x_sample, *mem_prompt, *cache_a_k, *cache_a_v, *state_b_conv, *state_b_C, *state_b_n,
      *state_b_m, *cache_mem_k, *cache_mem_v;
  const float *g_mix, *w_in, *conv_w, *conv_b, *b_if, *g_head, *rel_bias, *w_a_up, *w_b_up, *w_out, *g_mem, *w_mk,
      *w_mv, *g_cross, *w_cq, *w_co, *g_ffn, *w_pq, *sub_keys, *peer_u, *peer_v, *g_final;
  float* out;
  char* ws;
  int ph0, ph1;
};

__device__ __forceinline__ float bf2f(u16 h) { return __uint_as_float(((u32)h) << 16); }
__device__ __forceinline__ u32 pack2(float lo, float hi) {
  u32 r;
  asm("v_cvt_pk_bf16_f32 %0,%1,%2" : "=v"(r) : "v"(lo), "v"(hi));
  return r;
}
__device__ __forceinline__ u16 f2bf(float f) { return (u16)(pack2(f, 0.f) & 0xffffu); }
__device__ __forceinline__ float lo16(u32 w) { return __uint_as_float(w << 16); }
__device__ __forceinline__ float hi16(u32 w) { return __uint_as_float(w & 0xffff0000u); }

template <int CTRL>
__device__ __forceinline__ float dppf(float v) {
  return __int_as_float(__builtin_amdgcn_update_dpp(0, __float_as_int(v), CTRL, 0xF, 0xF, true));
}
template <int CTRL>
__device__ __forceinline__ u32 dppu(u32 v) {
  return (u32)__builtin_amdgcn_update_dpp(0, (int)v, CTRL, 0xF, 0xF, true);
}
__device__ __forceinline__ float row16_sum(float v) {
  v += dppf<0xB1>(v); v += dppf<0x4E>(v); v += dppf<0x141>(v); v += dppf<0x140>(v);
  return v;
}
__device__ __forceinline__ float row16_max(float v) {
  v = fmaxf(v, dppf<0xB1>(v)); v = fmaxf(v, dppf<0x4E>(v)); v = fmaxf(v, dppf<0x141>(v)); v = fmaxf(v, dppf<0x140>(v));
  return v;
}
__device__ __forceinline__ u32 umax2(u32 a, u32 b) { return a > b ? a : b; }
__device__ __forceinline__ u32 row16_umax(u32 v) {
  v = umax2(v, dppu<0xB1>(v)); v = umax2(v, dppu<0x4E>(v)); v = umax2(v, dppu<0x141>(v)); v = umax2(v, dppu<0x140>(v));
  return v;
}
__device__ __forceinline__ float wave_sum(float v) {
  v = row16_sum(v);
  v += __shfl_xor(v, 16);
  v += __shfl_xor(v, 32);
  return v;
}
__device__ __forceinline__ u32 ordk(float f) {
  u32 u = __float_as_uint(f);
  return u ^ ((u32)((int)u >> 31) | 0x80000000u);
}
__device__ __forceinline__ float unordk(u32 k) { return __uint_as_float(k ^ ((~(u32)((int)k >> 31)) | 0x80000000u)); }
__device__ __forceinline__ float sigmoidf_(float x) { return __builtin_amdgcn_rcpf(1.f + __expf(-x)); }
__device__ __forceinline__ uint4 zero4() { return make_uint4(0, 0, 0, 0); }

__device__ __forceinline__ void transpose_tile(const float* __restrict__ src, int src_ld, int k0, int c0, int col_lim,
                               u16* __restrict__ dst, int dst_ld, int dst_r0, float* tile) {
  const int tid = threadIdx.x, c = tid & 63, r4 = tid >> 6;
  {
    float tv[16];
    const int cc0 = c < col_lim ? c : 0;
#pragma unroll
    for (int i = 0; i < 16; i++) tv[i] = src[(size_t)(k0 + r4 + 4 * i) * src_ld + c0 + cc0];
#pragma unroll
    for (int i = 0; i < 16; i++) tile[(r4 + 4 * i) * 65 + c] = (c < col_lim) ? tv[i] : 0.f;
  }
  __syncthreads();
#pragma unroll 4
  for (int i = 0; i < 16; i++) {
    int cc = r4 + 4 * i;
    dst[(size_t)(dst_r0 + cc) * dst_ld + k0 + c] = f2bf(tile[c * 65 + cc]);
  }
  __syncthreads();
}

__device__ __forceinline__ void rms_row_to_bf16(const float* __restrict__ src, const float* __restrict__ g,
                                                u16* __restrict__ dst, int lane) {
  float4 v[4];
  float ss = 0.f;
#pragma unroll
  for (int i = 0; i < 4; i++) {
    v[i] = ((const float4*)src)[lane + 64 * i];
    ss += v[i].x * v[i].x + v[i].y * v[i].y + v[i].z * v[i].z + v[i].w * v[i].w;
  }
  ss = wave_sum(ss);
  float r = rsqrtf(ss * (1.f / 1024.f) + 1e-6f);
#pragma unroll
  for (int i = 0; i < 4; i++) {
    float4 gg = ((const float4*)g)[lane + 64 * i];
    uint2 o;
    o.x = pack2(v[i].x * r * gg.x, v[i].y * r * gg.y);
    o.y = pack2(v[i].z * r * gg.z, v[i].w * r * gg.w);
    ((uint2*)dst)[lane + 64 * i] = o;
  }
}

__device__ __forceinline__ void cvt_bf16(const float* __restrict__ src, u16* __restrict__ dst, size_t n) {
  size_t n8 = n >> 3;
  for (size_t i = (size_t)blockIdx.x * 256 + threadIdx.x; i < n8; i += (size_t)gridDim.x * 256) {
    float4 a = ((const float4*)src)[2 * i], b = ((const float4*)src)[2 * i + 1];
    uint4 o;
    o.x = pack2(a.x, a.y); o.y = pack2(a.z, a.w); o.z = pack2(b.x, b.y); o.w = pack2(b.z, b.w);
    ((uint4*)dst)[i] = o;
  }
}

__device__ __forceinline__ void cvt_fp8(const float* __restrict__ src, unsigned char* __restrict__ dst, size_t n, float scale) {
  size_t n16 = n >> 4;
  for (size_t i = (size_t)blockIdx.x * 256 + threadIdx.x; i < n16; i += (size_t)gridDim.x * 256) {
    const float4* sp = (const float4*)src + 4 * i;
    float4 a = sp[0], b = sp[1], c = sp[2], d = sp[3];
    int w0 = 0, w1 = 0, w2 = 0, w3 = 0;
    w0 = __builtin_amdgcn_cvt_pk_fp8_f32(a.x * scale, a.y * scale, w0, false);
    w0 = __builtin_amdgcn_cvt_pk_fp8_f32(a.z * scale, a.w * scale, w0, true);
    w1 = __builtin_amdgcn_cvt_pk_fp8_f32(b.x * scale, b.y * scale, w1, false);
    w1 = __builtin_amdgcn_cvt_pk_fp8_f32(b.z * scale, b.w * scale, w1, true);
    w2 = __builtin_amdgcn_cvt_pk_fp8_f32(c.x * scale, c.y * scale, w2, false);
    w2 = __builtin_amdgcn_cvt_pk_fp8_f32(c.z * scale, c.w * scale, w2, true);
    w3 = __builtin_amdgcn_cvt_pk_fp8_f32(d.x * scale, d.y * scale, w3, false);
    w3 = __builtin_amdgcn_cvt_pk_fp8_f32(d.z * scale, d.w * scale, w3, true);
    ((uint4*)dst)[i] = make_uint4((u32)w0, (u32)w1, (u32)w2, (u32)w3);
  }
}

__device__ __forceinline__ void phase_prep(const Params& p, char* smem) {
  float* tile = (float*)smem;
  char* ws = p.ws;
  if (blockIdx.x == 0 && threadIdx.x < 16) ((int*)(ws + OFF_CTR))[threadIdx.x] = 0;
  for (int j = blockIdx.x; j < 5536; j += gridDim.x) {
    if (j < 928) { int kt = j & 15, nt = j >> 4;
      transpose_tile(p.w_in, 5640, kt * 64, nt * 64, 3592 - nt * 64, (u16*)(ws + OFF_WT_IN), HLD, nt * 64, tile);
    } else if (j < 1440) { int q = j - 928; int kt = q & 15, nt = q >> 4;
      transpose_tile(p.w_in, 5640, kt * 64, 3592 + nt * 64, 64, (u16*)(ws + OFF_WT_IN), HLD, 3712 + nt * 64, tile);
    } else if (j < 1568) { int q = j - 1440; int kt = q & 7, nt = q >> 3;
      transpose_tile(p.w_a_up, 1024, kt * 64, nt * 64, 64, (u16*)(ws + OFF_WT_AUP), WLD5, nt * 64, tile);
    } else if (j < 1696) { int q = j - 1568; int kt = q & 7, nt = q >> 3;
      transpose_tile(p.w_b_up, 1024, kt * 64, nt * 64, 64, (u16*)(ws + OFF_WT_BUP), WLD5, nt * 64, tile);
    } else if (j < 1952) { int q = j - 1696; int kt = q & 15, nt = q >> 4;
      transpose_tile(p.w_out, 1024, kt * 64, nt * 64, 64, (u16*)(ws + OFF_WT_OUT), HLD, nt * 64, tile);
    } else if (j < 2208) { int q = j - 1952; int kt = q & 15, nt = q >> 4;
      transpose_tile(p.w_mk, 1024, kt * 64, nt * 64, 64, (u16*)(ws + OFF_WT_MKV), HLD, nt * 64, tile);
    } else if (j < 2464) { int q = j - 2208; int kt = q & 15, nt = q >> 4;
      transpose_tile(p.w_mv, 1024, kt * 64, nt * 64, 64, (u16*)(ws + OFF_WT_MKV), HLD, 1024 + nt * 64, tile);
    } else if (j < 2720) { int q = j - 2464; int kt = q & 15, nt = q >> 4;
      transpose_tile(p.w_cq, 1024, kt * 64, nt * 64, 64, (u16*)(ws + OFF_WT_CQ), HLD, nt * 64, tile);
    } else if (j < 2976) { int q = j - 2720; int kt = q & 15, nt = q >> 4;
      transpose_tile(p.w_co, 1024, kt * 64, nt * 64, 64, (u16*)(ws + OFF_WT_CO), HLD, nt * 64, tile);
    } else if (j < 3488) { int q = j - 2976; int kt = q & 15, nt = q >> 4;
      transpose_tile(p.w_pq, 2048, kt * 64, nt * 64, 64, (u16*)(ws + OFF_WT_PQ), HLD, nt * 64, tile);
    } else if (j < 4512) { int q = j - 3488; int kt = q & 7, nt = (q >> 3) & 7, sb = q >> 6;
      transpose_tile(p.cache_a_v + (size_t)sb * 512 * 512, 512, kt * 64, nt * 64, 64,
                     (u16*)(ws + OFF_VCT) + (size_t)sb * 512 * 512, 512, nt * 64, tile);
    } else { int q = j - 4512; int kt = q & 3, nt = (q >> 2) & 15, sb = q >> 6;
      transpose_tile(p.cache_mem_v + (size_t)sb * 256 * 1024, 1024, kt * 64, nt * 64, 64,
                     (u16*)(ws + OFF_MVT) + (size_t)(8 + sb) * 1024 * 256, 256, nt * 64, tile);
    }
  }
  const int lane = threadIdx.x & 63, gw = blockIdx.x * 4 + (threadIdx.x >> 6), nw = gridDim.x * 4;
  for (int r = gw; r < NT + 2048; r += nw) {
    if (r < NP) rms_row_to_bf16(p.x_prompt + (size_t)r * 1024, p.g_mix, (u16*)(ws + OFF_H) + (size_t)r * HLD, lane);
    else if (r < NT) rms_row_to_bf16(p.x_sample + (size_t)(r - NP) * 1024, p.g_mix, (u16*)(ws + OFF_H) + (size_t)r * HLD, lane);
    else rms_row_to_bf16(p.mem_prompt + (size_t)(r - NT) * 1024, p.g_mem, (u16*)(ws + OFF_MN) + (size_t)(r - NT) * HLD, lane);
  }
  cvt_bf16(p.cache_a_k, (u16*)(ws + OFF_KC), 16ull * 512 * 512);
  {
    u16* MKs = (u16*)(ws + OFF_MK) + 2048ull * HLD;
    for (size_t i = (size_t)blockIdx.x * 256 + threadIdx.x; i < 4096ull * 128; i += (size_t)gridDim.x * 256) {
      const size_t r = i >> 7, c8 = (i & 127) * 8;
      const float4 a = *(const float4*)(p.cache_mem_k + r * 1024 + c8), b = *(const float4*)(p.cache_mem_k + r * 1024 + c8 + 4);
      uint4 o;
      o.x = pack2(a.x, a.y); o.y = pack2(a.z, a.w); o.z = pack2(b.x, b.y); o.w = pack2(b.z, b.w);
      *(uint4*)(MKs + r * HLD + c8) = o;
    }
  }
  cvt_bf16(p.sub_keys, (u16*)(ws + OFF_SUBK), 262144);
}

__device__ __forceinline__ void lds_barrier() {
  asm volatile("s_waitcnt lgkmcnt(0)" ::: "memory");
  __builtin_amdgcn_s_barrier();
  asm volatile("" ::: "memory");
}

__device__ __forceinline__ void gemm_tile(const u16* __restrict__ A, int lda, const u16* __restrict__ Bt, int ldb, int K,
                                          int m0, int n0, u16* smem, f32x4 (&acc)[4][4]) {
  int tid = threadIdx.x;
  asm volatile("" : "+v"(tid));
  const int lane = tid & 63, wave = tid >> 6;
  const int wr = wave >> 1, wc = wave & 1, col = lane & 15, grp = lane >> 4;
  const int c4 = lane & 3, r1 = (lane >> 2) & 1, half = (lane >> 3) & 1, r2 = lane >> 4;
  const int lrow = wave * 8 + r2 * 2 + r1;
  char* As = (char*)smem;
  char* Bs = As + 2 * 16384;
  int wofs;
  {
    const int ob = (lrow & 15) * 64 + c4 * 16;
    wofs = ((lrow >> 4) * 2 + half) * 1024 + (ob ^ (((ob >> 9) & 1) << 5));
  }
  int rofs;
  {
    const int ob = col * 64 + grp * 16;
    rofs = ob ^ (((ob >> 9) & 1) << 5);
  }
  const int aofs = rofs + wr * 8192, bofs = rofs + wc * 8192;
  const u16* Ag = A + (size_t)(m0 + lrow) * lda + half * 32 + c4 * 8;
  const u16* Bg = Bt + (size_t)(n0 + lrow) * ldb + half * 32 + c4 * 8;
  uint4 r0a0, r0a1, r0a2, r0a3, r0b0, r0b1, r0b2, r0b3;
  uint4 r1a0, r1a1, r1a2, r1a3, r1b0, r1b1, r1b2, r1b3;
#define G_LOAD(S, KO)                                                                               \
  S##a0 = *(const uint4*)(Ag + (KO)); S##a1 = *(const uint4*)(Ag + (size_t)32 * lda + (KO));         \
  S##a2 = *(const uint4*)(Ag + (size_t)64 * lda + (KO)); S##a3 = *(const uint4*)(Ag + (size_t)96 * lda + (KO)); \
  S##b0 = *(const uint4*)(Bg + (KO)); S##b1 = *(const uint4*)(Bg + (size_t)32 * ldb + (KO));         \
  S##b2 = *(const uint4*)(Bg + (size_t)64 * ldb + (KO)); S##b3 = *(const uint4*)(Bg + (size_t)96 * ldb + (KO));
#define G_STORE(S, AP, BP)                                                                           \
  *(uint4*)((AP) + wofs) = S##a0; *(uint4*)((AP) + wofs + 4096) = S##a1;                             \
  *(uint4*)((AP) + wofs + 8192) = S##a2; *(uint4*)((AP) + wofs + 12288) = S##a3;                     \
  *(uint4*)((BP) + wofs) = S##b0; *(uint4*)((BP) + wofs + 4096) = S##b1;                             \
  *(uint4*)((BP) + wofs + 8192) = S##b2; *(uint4*)((BP) + wofs + 12288) = S##b3;
#define G_COMPUTE(CUR)                                                                               \
  {                                                                                                  \
    const char* Ac = As + (CUR) * 16384 + aofs;                                                      \
    const char* Bc = Bs + (CUR) * 16384 + bofs;                                                      \
    _Pragma("unroll") for (int ks = 0; ks < 2; ks++) {                                               \
      bf16x8 af0, af1, af2, af3, bq0, bq1, bq2, bq3;                                                 \
      af0 = *(const bf16x8*)(Ac + 0 * 2048 + ks * 1024);                                             \
      af1 = *(const bf16x8*)(Ac + 1 * 2048 + ks * 1024);                                             \
      af2 = *(const bf16x8*)(Ac + 2 * 2048 + ks * 1024);                                             \
      af3 = *(const bf16x8*)(Ac + 3 * 2048 + ks * 1024);                                             \
      bq0 = *(const bf16x8*)(Bc + 0 * 2048 + ks * 1024);                                             \
      bq1 = *(const bf16x8*)(Bc + 1 * 2048 + ks * 1024);                                             \
      bq2 = *(const bf16x8*)(Bc + 2 * 2048 + ks * 1024);                                             \
      bq3 = *(const bf16x8*)(Bc + 3 * 2048 + ks * 1024);                                             \
      acc[0][0] = MFMA(af0, bq0, acc[0][0]); acc[0][1] = MFMA(af0, bq1, acc[0][1]);                  \
      acc[0][2] = MFMA(af0, bq2, acc[0][2]); acc[0][3] = MFMA(af0, bq3, acc[0][3]);                  \
      acc[1][0] = MFMA(af1, bq0, acc[1][0]); acc[1][1] = MFMA(af1, bq1, acc[1][1]);                  \
      acc[1][2] = MFMA(af1, bq2, acc[1][2]); acc[1][3] = MFMA(af1, bq3, acc[1][3]);                  \
      acc[2][0] = MFMA(af2, bq0, acc[2][0]); acc[2][1] = MFMA(af2, bq1, acc[2][1]);                  \
      acc[2][2] = MFMA(af2, bq2, acc[2][2]); acc[2][3] = MFMA(af2, bq3, acc[2][3]);                  \
      acc[3][0] = MFMA(af3, bq0, acc[3][0]); acc[3][1] = MFMA(af3, bq1, acc[3][1]);                  \
      acc[3][2] = MFMA(af3, bq2, acc[3][2]); acc[3][3] = MFMA(af3, bq3, acc[3][3]);                  \
    }                                                                                                \
  }
#define G_STEP(KT, SS)                                                       \
  {                                                                          \
    __builtin_amdgcn_s_setprio(1);                                           \
    G_COMPUTE((KT) & 1)                                                      \
    __builtin_amdgcn_s_setprio(0);                                           \
    G_STORE(SS, As + (((KT) + 1) & 1) * 16384, Bs + (((KT) + 1) & 1) * 16384) \
    { const int kn = min((KT) + 3, nk - 1) * 64; G_LOAD(SS, kn) }            \
    lds_barrier();                                                           \
  }
  const int nk = K >> 6;
  G_LOAD(r0, 0)
  G_LOAD(r1, 64)
  G_STORE(r0, As, Bs)
  G_LOAD(r0, 128)
  lds_barrier();
#pragma unroll 1
  for (int kt = 0; kt < nk; kt += 2) {
    G_STEP(kt, r1)
    G_STEP(kt + 1, r0)
  }
  lds_barrier();
#undef G_LOAD
#undef G_STORE
#undef G_COMPUTE
#undef G_STEP
}

__device__ __forceinline__ bool sched_tile(int NTM, int NTN, int xcd, int j, int& mt, int& nt) {
  const int mb = (NTM * xcd) >> 3, me = (NTM * (xcd + 1)) >> 3, nm = me - mb;
  if (j >= nm * NTN) return false;
  const int nfull = nm >> 3, fullcnt = nfull * 8 * NTN;
  if (j < fullcnt) {
    const int mg = j / (8 * NTN), r = j - mg * 8 * NTN;
    nt = r >> 3; mt = mb + mg * 8 + (r & 7);
  } else {
    const int r = j - fullcnt, gsz = nm - nfull * 8;
    nt = r / gsz; mt = mb + nfull * 8 + (r - nt * gsz);
  }
  return true;
}

constexpr int TLD = 136;
template <bool TR>
__device__ __forceinline__ void epi_stage(f32x4 (&acc)[4][4], u16* T) {
  int lane = threadIdx.x & 63;
  asm volatile("" : "+v"(lane));
  const int wave = threadIdx.x >> 6, wr = wave >> 1, wc = wave & 1, col = lane & 15, grp = lane >> 4;
#pragma unroll
  for (int m = 0; m < 4; m++)
#pragma unroll
    for (int n = 0; n < 4; n++) {
      const int r = wr * 64 + m * 16 + grp * 4, c = wc * 64 + n * 16 + col;
      if (TR) {
        uint2 o; o.x = pack2(acc[m][n][0], acc[m][n][1]); o.y = pack2(acc[m][n][2], acc[m][n][3]);
        *(uint2*)(T + c * TLD + r) = o;
      } else {
#pragma unroll
        for (int j = 0; j < 4; j++) T[(r + j) * TLD + c] = f2bf(acc[m][n][j]);
      }
    }
  lds_barrier();
}
#define EPI_CHUNKS(T, ...)                                              \
  {                                                                     \
    int _t = threadIdx.x;                                               \
    asm volatile("" : "+v"(_t));                                        \
    _Pragma("unroll") for (int _i = 0; _i < 8; _i++) {                  \
      const int _ch = _t + 256 * _i;                                    \
      const int r = _ch >> 4, c8 = (_ch & 15) * 8;                      \
      const uint4 v = *(const uint4*)((T) + r * TLD + c8);              \
      __VA_ARGS__                                                       \
    }                                                                   \
    lds_barrier();                                                      \
  }

#define ACC_ZERO(acc)                                   \
  _Pragma("unroll") for (int m = 0; m < 4; m++)          \
  _Pragma("unroll") for (int n = 0; n < 4; n++) acc[m][n] = f32x4{0.f, 0.f, 0.f, 0.f};

#define EPI_LOOP(acc, m0, n0, ...)                                                               \
  {                                                                                              \
    int _lane = threadIdx.x & 63; const int _wave = threadIdx.x >> 6;                            \
    asm volatile("" : "+v"(_lane));                                                            \
    const int _wr = _wave >> 1, _wc = _wave & 1;                                                 \
    _Pragma("unroll") for (int m = 0; m < 4; m++) _Pragma("unroll") for (int n = 0; n < 4; n++) { \
      const int row = (m0) + _wr * 64 + m * 16 + (_lane >> 4) * 4;                               \
      const int colg = (n0) + _wc * 64 + n * 16 + (_lane & 15);                                  \
      f32x4 v = acc[m][n];                                                                       \
      __VA_ARGS__                                                                                \
    }                                                                                            \
  }

__device__ __forceinline__ void phase_gemm_in(const Params& p, char* smem) {
  char* ws = p.ws;
  const u16* H = (const u16*)(ws + OFF_H);
  u16* Z = (u16*)(ws + OFF_Z);
  u16* VAT = (u16*)(ws + OFF_VAT);
  u16* VBT = (u16*)(ws + OFF_VBT);
  u16* G = (u16*)(p.out);
  const int xcd = blockIdx.x & 7, slot = blockIdx.x >> 3, nslots = gridDim.x >> 3;
  for (int pass = 0; pass < 2; pass++)
  for (int j = slot;; j += nslots) {
    int mt, nt;
    if (!sched_tile(pass == 0 ? 132 : 16, pass == 0 ? 45 : 16, xcd, j, mt, nt)) break;
    f32x4 acc[4][4];
    ACC_ZERO(acc);
    if (pass == 0) {
      const int m0 = mt * 128, n0 = nt * 128;
      gemm_tile(H, HLD, (const u16*)(ws + OFF_WT_IN), HLD, 1024, m0, n0, (u16*)smem, acc);
      u16* T = (u16*)smem;
      if (nt >= 29) {
        epi_stage<false>(acc, T);
        const int ng = n0 - 3712;
        EPI_CHUNKS(T, {
          const int row = m0 + r;
          *(uint4*)(G + (size_t)row * 2048 + ((ng + (row & 15) * 128) & 2047) + c8) = v;
        })
      } else if (nt >= 8 && nt < 12) {
        epi_stage<true>(acc, T);
        EPI_CHUNKS(T, { *(uint4*)(VAT + (size_t)(n0 - 1024 + r) * VLD + m0 + c8) = v; })
      } else if (nt >= 20 && nt < 24) {
        epi_stage<true>(acc, T);
        EPI_CHUNKS(T, { *(uint4*)(VBT + (size_t)(n0 - 2560 + r) * VLD + m0 + c8) = v; })
      } else {
        epi_stage<false>(acc, T);
        EPI_CHUNKS(T, { *(uint4*)(Z + (size_t)(m0 + r) * ZLD + n0 + c8) = v; })
      }
    } else {
      const int m0 = mt * 128, n0 = nt * 128;
      gemm_tile((const u16*)(ws + OFF_MN), HLD, (const u16*)(ws + OFF_WT_MKV), HLD, 1024, m0, n0, (u16*)smem, acc);
      if (nt < 8) {
        u16* MK = (u16*)(ws + OFF_MK);
        float* o = p.out + O_PMK;
        EPI_LOOP(acc, m0, n0, {
          _Pragma("unroll") for (int j = 0; j < 4; j++) {
            o[(size_t)(row + j) * 1024 + colg] = v[j];
            MK[(size_t)(row + j) * HLD + colg] = f2bf(v[j]);
          }
        })
      } else {
        u16* MVT = (u16*)(ws + OFF_MVT);
        float* o = p.out + O_PMV;
        EPI_LOOP(acc, m0, n0 - 1024, {
          _Pragma("unroll") for (int j = 0; j < 4; j++) o[(size_t)(row + j) * 1024 + colg] = v[j];
          uint2 w; w.x = pack2(v[0], v[1]); w.y = pack2(v[2], v[3]);
          const int b = row >> 8, mm = row & 255;
          *(uint2*)(MVT + ((size_t)b * 1024 + colg) * 256 + mm) = w;
        })
      }
    }
  }
}

__device__ __forceinline__ void phase_conv(const Params& p) {
  const u16* Z = (const u16*)(p.ws + OFF_Z);
  u16* QK = (u16*)(p.ws + OFF_H);
  for (int idx = blockIdx.x * 256 + threadIdx.x; idx < NT * 128; idx += gridDim.x * 256) {
    const int row = idx >> 7, c0 = (idx & 127) * 8;
    const bool samp = row >= NP;
    const int t = samp ? ((row - NP) & 31) : (row & 2047);
    const int sb = (row - NP) >> 5;
    float acc[8];
    {
      float4 b0 = *(const float4*)(p.conv_b + c0), b1 = *(const float4*)(p.conv_b + c0 + 4);
      acc[0] = b0.x; acc[1] = b0.y; acc[2] = b0.z; acc[3] = b0.w; acc[4] = b1.x; acc[5] = b1.y; acc[6] = b1.z; acc[7] = b1.w;
    }
    uint4 zw[4];
#pragma unroll
    for (int d = 0; d < 4; d++) zw[d] = *(const uint4*)(Z + (size_t)(row - min(d, t)) * ZLD + 1536 + c0);
#pragma unroll
    for (int d = 0; d < 4; d++) {
      float u[8];
      const uint4 w = zw[d];
      u[0] = lo16(w.x); u[1] = hi16(w.x); u[2] = lo16(w.y); u[3] = hi16(w.y);
      u[4] = lo16(w.z); u[5] = hi16(w.z); u[6] = lo16(w.w); u[7] = hi16(w.w);
      if (t - d < 0) {
        if (samp) {
          const float* pr = p.state_b_conv + (size_t)(sb * 3 + (3 + t - d)) * 1024 + c0;
          float4 a = *(const float4*)pr, b = *(const float4*)(pr + 4);
          u[0] = a.x; u[1] = a.y; u[2] = a.z; u[3] = a.w; u[4] = b.x; u[5] = b.y; u[6] = b.z; u[7] = b.w;
        } else {
#pragma unroll
          for (int e = 0; e < 8; e++) u[e] = 0.f;
        }
      }
      const float* wp = p.conv_w + (3 - d) * 1024 + c0;
      float4 w0 = *(const float4*)wp, w1 = *(const float4*)(wp + 4);
      acc[0] += u[0] * w0.x; acc[1] += u[1] * w0.y; acc[2] += u[2] * w0.z; acc[3] += u[3] * w0.w;
      acc[4] += u[4] * w1.x; acc[5] += u[5] * w1.y; acc[6] += u[6] * w1.z; acc[7] += u[7] * w1.w;
    }
    const float sc = (c0 >= 512) ? 0.08838834764831845f : 1.f;
#pragma unroll
    for (int e = 0; e < 8; e++) acc[e] = acc[e] * sigmoidf_(acc[e]) * sc;
    uint4 o;
    o.x = pack2(acc[0], acc[1]); o.y = pack2(acc[2], acc[3]); o.z = pack2(acc[4], acc[5]); o.w = pack2(acc[6], acc[7]);
    *(uint4*)(QK + (size_t)row * HLD + c0) = o;
  }
}

struct AttnTile { const u16* k; int ldk; const u16* vt; int ldvt; int nvalid; int kpos0; };

template <int DH, class TileFn>
__device__ __forceinline__ void attn_item(const u16* __restrict__ Q, int ldq, int qvalid, u16* __restrict__ O, int ldo, int ntiles,
                          TileFn tf, const float* __restrict__ biasG, int qpos0, float scale, char* smem) {
  constexpr int KLD = DH + 8, NKS = DH / 32, NDT = DH / 16, CPT = DH / 32;
  u16* Ks = (u16*)smem;
  u16* VTs = Ks + 64 * KLD;
  u16* Ps = VTs + DH * 72;
  float* biasS = (float*)(Ps + 4 * 16 * 72);
  int tid = threadIdx.x;
  asm volatile("" : "+v"(tid));
  const int lane = tid & 63, wave = tid >> 6, col = lane & 15, grp = lane >> 4;
  const float L2E = 1.4426950408889634f;
  bf16x8 qf[NKS];
  {
    const int qr = wave * 16 + col;
    const bool ok = qr < qvalid;
#pragma unroll
    for (int ks = 0; ks < NKS; ks++) {
      uint4 w = ok ? *(const uint4*)(Q + (size_t)qr * ldq + ks * 32 + grp * 8) : zero4();
      qf[ks] = *(bf16x8*)&w;
    }
  }
  lds_barrier();
  if (biasG) for (int i = tid; i < 257; i += 256) biasS[i] = biasG[i];
  f32x4 oacc[NDT];
#pragma unroll
  for (int i = 0; i < NDT; i++) oacc[i] = f32x4{0.f, 0.f, 0.f, 0.f};
  float mrun[4], lrun[4];
#pragma unroll
  for (int i = 0; i < 4; i++) { mrun[i] = -INFINITY; lrun[i] = 0.f; }
  uint4 pk_[CPT], pv_[CPT];
  if (DH == 64) {
    const AttnTile T0 = tf(0);
    const int n01 = T0.nvalid - 1;
#pragma unroll
    for (int i = 0; i < CPT; i++) {
      const int c = tid + 256 * i;
      const int key = c / (DH / 8), dc = c % (DH / 8);
      pk_[i] = *(const uint4*)(T0.k + (size_t)min(key, n01) * T0.ldk + dc * 8);
      const int d = c >> 3, kc = c & 7;
      pv_[i] = *(const uint4*)(T0.vt + (size_t)d * T0.ldvt + min(kc * 8, (n01 >> 3) * 8));
    }
  }
#pragma unroll 1
  for (int j = 0; j < ntiles; j++) {
    AttnTile T = tf(j);
    int tidL = tid;
    asm volatile("" : "+v"(tidL));
    lds_barrier();
    const int nvm1 = T.nvalid - 1;
    if (DH == 64) {
#pragma unroll
      for (int i = 0; i < CPT; i++) {
        const int c = tidL + 256 * i;
        const int key = c / (DH / 8), dc = c % (DH / 8);
        *(uint4*)(Ks + key * KLD + dc * 8) = key <= nvm1 ? pk_[i] : zero4();
        const int d = c >> 3, kc = c & 7;
        *(uint4*)(VTs + d * 72 + kc * 8) = (kc * 8 <= nvm1) ? pv_[i] : zero4();
      }
    } else {
      uint4 kv[CPT];
#pragma unroll
      for (int i = 0; i < CPT; i++) {
        const int c = tidL + 256 * i;
        const int key = c / (DH / 8), dc = c % (DH / 8);
        kv[i] = *(const uint4*)(T.k + (size_t)min(key, nvm1) * T.ldk + dc * 8);
      }
#pragma unroll
      for (int i = 0; i < CPT; i++) {
        const int c = tidL + 256 * i;
        const int key = c / (DH / 8), dc = c % (DH / 8);
        *(uint4*)(Ks + key * KLD + dc * 8) = key <= nvm1 ? kv[i] : zero4();
      }
#pragma unroll
      for (int i = 0; i < CPT; i++) {
        const int c = tidL + 256 * i;
        const int d = c >> 3, kc = c & 7;
        kv[i] = *(const uint4*)(T.vt + (size_t)d * T.ldvt + min(kc * 8, (nvm1 >> 3) * 8));
      }
#pragma unroll
      for (int i = 0; i < CPT; i++) {
        const int c = tidL + 256 * i;
        const int d = c >> 3, kc = c & 7;
        *(uint4*)(VTs + d * 72 + kc * 8) = (kc * 8 <= nvm1) ? kv[i] : zero4();
      }
    }
    lds_barrier();
    if (DH == 64 && j + 1 < ntiles) {
      const AttnTile Tn = tf(j + 1);
      const int nn1 = Tn.nvalid - 1;
#pragma unroll
      for (int i = 0; i < CPT; i++) {
        const int c = tidL + 256 * i;
        const int key = c / (DH / 8), dc = c % (DH / 8);
        pk_[i] = *(const uint4*)(Tn.k + (size_t)min(key, nn1) * Tn.ldk + dc * 8);
        const int d = c >> 3, kc = c & 7;
        pv_[i] = *(const uint4*)(Tn.vt + (size_t)d * Tn.ldvt + min(kc * 8, (nn1 >> 3) * 8));
      }
    }
    f32x4 s[4];
#pragma unroll
    for (int n = 0; n < 4; n++) s[n] = f32x4{0.f, 0.f, 0.f, 0.f};
#pragma unroll
    for (int ks = 0; ks < NKS; ks++)
#pragma unroll
      for (int n = 0; n < 4; n++) {
        bf16x8 kf = *(const bf16x8*)(Ks + (n * 16 + col) * KLD + ks * 32 + grp * 8);
        s[n] = MFMA(qf[ks], kf, s[n]);
      }
    float mx[4] = {-INFINITY, -INFINITY, -INFINITY, -INFINITY};
#pragma unroll
    for (int n = 0; n < 4; n++)
#pragma unroll
      for (int i = 0; i < 4; i++) {
        const int key = n * 16 + col;
        float v = s[n][i] * scale;
        if (biasG) {
          int rel = qpos0 + wave * 16 + grp * 4 + i - (T.kpos0 + key);
          rel = min(max(rel, -128), 128) + 128;
          v += biasS[rel];
        }
        if (key >= T.nvalid) v = -INFINITY;
        s[n][i] = v;
        mx[i] = fmaxf(mx[i], v);
      }
    float alpha[4], lsum[4];
#pragma unroll
    for (int i = 0; i < 4; i++) {
      float m2 = fmaxf(mrun[i], row16_max(mx[i]));
      alpha[i] = exp2f((mrun[i] - m2) * L2E);
      mrun[i] = m2;
      lsum[i] = 0.f;
    }
#pragma unroll
    for (int n = 0; n < 4; n++)
#pragma unroll
      for (int i = 0; i < 4; i++) {
        float pv = exp2f((s[n][i] - mrun[i]) * L2E);
        lsum[i] += pv;
        Ps[(wave * 16 + grp * 4 + i) * 72 + n * 16 + col] = f2bf(pv);
      }
#pragma unroll
    for (int i = 0; i < 4; i++) lrun[i] = lrun[i] * alpha[i] + lsum[i];
#pragma unroll
    for (int nd = 0; nd < NDT; nd++)
#pragma unroll
      for (int i = 0; i < 4; i++) oacc[nd][i] *= alpha[i];
    asm volatile("s_waitcnt lgkmcnt(0)" ::: "memory");
#pragma unroll
    for (int k2 = 0; k2 < 2; k2++) {
      bf16x8 pf = *(const bf16x8*)(Ps + (wave * 16 + col) * 72 + k2 * 32 + grp * 8);
#pragma unroll
      for (int nd = 0; nd < NDT; nd++) {
        bf16x8 vf = *(const bf16x8*)(VTs + (nd * 16 + col) * 72 + k2 * 32 + grp * 8);
        oacc[nd] = MFMA(pf, vf, oacc[nd]);
      }
    }
  }
  int rowb = wave * 16 + grp * 4;
  asm volatile("" : "+v"(rowb));
#pragma unroll
  for (int i = 0; i < 4; i++) {
    float l = row16_sum(lrun[i]);
    float inv = __builtin_amdgcn_rcpf(l);
    const int row = rowb + i;
    if (row < qvalid) {
#pragma unroll
      for (int nd = 0; nd < NDT; nd++) O[(size_t)row * ldo + nd * 16 + col] = f2bf(oacc[nd][i] * inv);
    }
  }
}

template <int MODE>
__device__ __forceinline__ void mlstm_item(const Params& p, int item, char* smem) {
  int tid = threadIdx.x;
  asm volatile("" : "+v"(tid));
  const int lane = tid & 63, wave = __builtin_amdgcn_readfirstlane(tid >> 6), col = lane & 15, grp = lane >> 4;
  u16* Z = (u16*)(p.ws + OFF_Z);
  const u16* QK = (const u16*)(p.ws + OFF_H);
  const u16* VBT = (const u16*)(p.ws + OFF_VBT);
  const bool sample = (MODE == 0);
  int h, L, nchunks, row0, bh;
  float *outC = nullptr, *outN = nullptr, *outM = nullptr;
  const u16* CT = nullptr;
  if (MODE == 1) {
    bh = item >> 5; h = bh & 3; L = 64; nchunks = 1; row0 = (bh >> 2) * 2048 + (item & 31) * 64;
    CT = (const u16*)(p.ws + OFF_DELTA) + (size_t)item * 16384;
  } else {
    bh = item; h = bh & 3; L = 32; nchunks = 1; row0 = NP + (bh >> 2) * 32;
    outC = p.out + O_SBC + (size_t)bh * 16384; outN = p.out + O_SBN + bh * 128; outM = p.out + O_SBM + bh;
  }
  u16* Qs = (u16*)smem;
  u16* Ks = Qs + 64 * 136;
  u16* As = Ks;
  u16* KTs = Ks + 64 * 136;
  u16* VTs = KTs + 128 * 72;
  float* fS = (float*)(VTs + 128 * 72);
  float *gS = fS, *MS = fS + 64, *wiS = fS + 128, *emS = fS + 192, *wsS = fS + 256, *denS = fS + 320,
        *ssqS = fS + 384, *nS = fS + 640, *misc = fS + 768;
  f32x4 Cst[8][2];
  const float bif_i = p.b_if[h], bif_f = p.b_if[4 + h];
  lds_barrier();
  if (MODE == 1) {
    if (tid < 128) nS[tid] = ((const float*)(p.ws + OFF_NBUF))[(size_t)item * 128 + tid];
    if (tid == 0) misc[0] = ((const float*)(p.ws + OFF_SCAL))[item * 4 + 2];
  } else if (sample) {
    const float* C0 = p.state_b_C + (size_t)bh * 16384;
    int ibase = grp * 512 + 32 * wave + col;
    asm volatile("" : "+v"(ibase));
#pragma unroll
    for (int mt = 0; mt < 8; mt++)
#pragma unroll
      for (int nn = 0; nn < 2; nn++)
#pragma unroll
        for (int i = 0; i < 4; i++) Cst[mt][nn][i] = C0[(16 * mt + i) * 128 + 16 * nn + ibase];
    if (tid < 128) nS[tid] = p.state_b_n[bh * 128 + tid];
    if (tid == 0) misc[0] = p.state_b_m[bh];
  } else {
#pragma unroll
    for (int mt = 0; mt < 8; mt++)
#pragma unroll
      for (int nn = 0; nn < 2; nn++) Cst[mt][nn] = f32x4{0.f, 0.f, 0.f, 0.f};
    if (tid < 128) nS[tid] = 0.f;
    if (tid == 0) misc[0] = 0.f;
  }
  u16 gpre_i = 0, gpre_f = 0;
  if (wave == 0) {
    const u16* zg = Z + (size_t)(row0 + min(lane, L - 1)) * ZLD + 3584 + h;
    gpre_i = zg[0]; gpre_f = zg[4];
  }
#pragma unroll 1
  for (int c = 0; c < nchunks; c++) {
    int r0 = row0 + c * 64;
    int tidL = tid, colL = col, grpL = grp;
    asm volatile("" : "+v"(r0), "+v"(tidL), "+v"(colL), "+v"(grpL));
    lds_barrier();
    if (wave == 0) {
      const int t = lane;
      float ig = -INFINITY, lf = 0.f;
      {
        const float zi = bf2f(gpre_i) + bif_i, zf = bf2f(gpre_f) + bif_f;
        if (c + 1 < nchunks) {
          const u16* zg = Z + (size_t)(r0 + 64 + t) * ZLD + 3584 + h;
          gpre_i = zg[0]; gpre_f = zg[4];
        }
        if (t < L) {
          ig = zi;
          lf = fminf(zf, 0.f) - log1pf(__expf(-fabsf(zf)));
        }
      }
      float b = lf;
#pragma unroll
      for (int o = 1; o < 64; o <<= 1) { float y = __shfl_up(b, o); if (lane >= o) b += y; }
      const float g = ig - b;
      const float m0 = misc[0];
      float M = g;
#pragma unroll
      for (int o = 1; o < 64; o <<= 1) { float y = __shfl_up(M, o); if (lane >= o) M = fmaxf(M, y); }
      M = fmaxf(M, m0);
      const float Mend = __shfl(M, 63), bl = __shfl(b, 63);
      gS[t] = g; MS[t] = M; wiS[t] = __expf(m0 - M); emS[t] = __expf(-(b + M)); wsS[t] = __expf(g - Mend);
      if (lane == 0) { misc[1] = __expf(m0 - Mend); misc[2] = bl + Mend; }
    }
    lds_barrier();
    {
      uint4 qv[4], kv[4], vv[4];
      const int Lm1 = L - 1;
      const int s_ = tidL & 63;
#pragma unroll
      for (int i = 0; i < 4; i++) {
        const int ci = tidL + 256 * i;
        const int t = ci >> 4, dc = ci & 15;
        qv[i] = *(const uint4*)(QK + (size_t)(r0 + min(t, Lm1)) * HLD + h * 128 + dc * 8);
        const int dk = (tidL >> 6) + 4 * i;
        kv[i] = *(const uint4*)(QK + (size_t)(r0 + min(s_, Lm1)) * HLD + 512 + h * 128 + dk * 8);
        const int vd = ci >> 3, sc = ci & 7;
        vv[i] = *(const uint4*)(VBT + (size_t)(h * 128 + vd) * VLD + r0 + min(sc * 8, (Lm1 >> 3) * 8));
      }
      const float wsv = wsS[s_];
#pragma unroll
      for (int i = 0; i < 4; i++) {
        const int ci = tidL + 256 * i;
        const int t = ci >> 4, dc = ci & 15;
        *(uint4*)(Qs + t * 136 + dc * 8) = t <= Lm1 ? qv[i] : zero4();
        const int dk = (tidL >> 6) + 4 * i;
        const uint4 v = s_ <= Lm1 ? kv[i] : zero4();
        *(uint4*)(Ks + s_ * 136 + dk * 8) = v;
        const u32 w[4] = {v.x, v.y, v.z, v.w};
#pragma unroll
        for (int e = 0; e < 4; e++) {
          KTs[(dk * 8 + 2 * e) * 72 + s_] = f2bf(lo16(w[e]) * wsv);
          KTs[(dk * 8 + 2 * e + 1) * 72 + s_] = f2bf(hi16(w[e]) * wsv);
        }
        const int vd = ci >> 3, sc = ci & 7;
        *(uint4*)(VTs + vd * 72 + sc * 8) = (sc * 8 <= Lm1) ? vv[i] : zero4();
      }
    }
    lds_barrier();
    f32x4 sacc[4];
#pragma unroll
    for (int n = 0; n < 4; n++) sacc[n] = f32x4{0.f, 0.f, 0.f, 0.f};
#pragma unroll
    for (int ks = 0; ks < 4; ks++) {
      bf16x8 qa = *(const bf16x8*)(Qs + (wave * 16 + col) * 136 + ks * 32 + grp * 8);
#pragma unroll
      for (int n = 0; n < 4; n++)
        if (n <= wave) {
          bf16x8 kb = *(const bf16x8*)(Ks + (n * 16 + col) * 136 + ks * 32 + grp * 8);
          sacc[n] = MFMA(qa, kb, sacc[n]);
        }
    }
#pragma unroll
    for (int n = 0; n < 4; n++)
#pragma unroll
      for (int i = 0; i < 4; i++) {
        const int t = wave * 16 + grp * 4 + i, s = n * 16 + col;
        const float dec = __expf(gS[s] - MS[t]);
        sacc[n][i] = (s <= t) ? sacc[n][i] * dec : 0.f;
      }
    lds_barrier();
#pragma unroll
    for (int n = 0; n < 4; n++)
#pragma unroll
      for (int i = 0; i < 4; i++) As[(wave * 16 + grp * 4 + i) * 72 + n * 16 + col] = f2bf(sacc[n][i]);
    lds_barrier();
    {
      f32x4 d1 = f32x4{0.f, 0.f, 0.f, 0.f}, d2 = f32x4{0.f, 0.f, 0.f, 0.f};
      const u32 one2 = (col == 0) ? 0x3F803F80u : 0u;
      uint4 ow = make_uint4(one2, one2, one2, one2);
      bf16x8 ones = *(bf16x8*)&ow;
#pragma unroll
      for (int ks = 0; ks < 2; ks++)
        if (ks == 0 || wave >= 2) {
          bf16x8 aa = *(const bf16x8*)(As + (wave * 16 + col) * 72 + ks * 32 + grp * 8);
          d1 = MFMA(aa, ones, d1);
        }
#pragma unroll
      for (int ks = 0; ks < 4; ks++) {
        uint4 w = zero4();
        if (col == 0) {
          const float* np_ = nS + ks * 32 + grp * 8;
          w.x = pack2(np_[0], np_[1]); w.y = pack2(np_[2], np_[3]); w.z = pack2(np_[4], np_[5]); w.w = pack2(np_[6], np_[7]);
        }
        bf16x8 nf = *(bf16x8*)&w;
        bf16x8 qa = *(const bf16x8*)(Qs + (wave * 16 + col) * 136 + ks * 32 + grp * 8);
        d2 = MFMA(qa, nf, d2);
      }
      if (col == 0) {
#pragma unroll
        for (int i = 0; i < 4; i++) { const int t = wave * 16 + grp * 4 + i; denS[t] = d1[i] + wiS[t] * d2[i]; }
      }
    }
    lds_barrier();
    bf16x8 cb[4][2];
#pragma unroll
    for (int j = 0; j < 4; j++)
#pragma unroll
      for (int nn = 0; nn < 2; nn++) {
        uint4 w;
        if (MODE == 1) {
          w = *(const uint4*)(CT + (size_t)(32 * wave + 16 * nn + col) * 128 + 32 * j + grp * 8);
        } else {
          w.x = pack2(Cst[2 * j][nn][0], Cst[2 * j][nn][1]);
          w.y = pack2(Cst[2 * j][nn][2], Cst[2 * j][nn][3]);
          w.z = pack2(Cst[2 * j + 1][nn][0], Cst[2 * j + 1][nn][1]);
          w.w = pack2(Cst[2 * j + 1][nn][2], Cst[2 * j + 1][nn][3]);
        }
        cb[j][nn] = *(bf16x8*)&w;
      }
    u32 hreg[4][4];
#pragma unroll
    for (int m = 0; m < 4; m++) {
      f32x4 av[2], qc[2];
#pragma unroll
      for (int nn = 0; nn < 2; nn++) { av[nn] = f32x4{0.f, 0.f, 0.f, 0.f}; qc[nn] = f32x4{0.f, 0.f, 0.f, 0.f}; }
#pragma unroll
      for (int ks = 0; ks < 2; ks++)
        if (ks == 0 || m >= 2) {
          bf16x8 aa = *(const bf16x8*)(As + (m * 16 + col) * 72 + ks * 32 + grp * 8);
#pragma unroll
          for (int nn = 0; nn < 2; nn++) {
            bf16x8 vb = *(const bf16x8*)(VTs + (32 * wave + 16 * nn + col) * 72 + ks * 32 + grp * 8);
            av[nn] = MFMA(aa, vb, av[nn]);
          }
        }
#pragma unroll
      for (int j = 0; j < 4; j++) {
        uint4 w;
        if (MODE == 1) {
          w = *(const uint4*)(Qs + (m * 16 + col) * 136 + 32 * j + 8 * grp);
        } else {
          uint2 a0 = *(const uint2*)(Qs + (m * 16 + col) * 136 + 32 * j + 4 * grp);
          uint2 a1 = *(const uint2*)(Qs + (m * 16 + col) * 136 + 32 * j + 16 + 4 * grp);
          w = make_uint4(a0.x, a0.y, a1.x, a1.y);
        }
        bf16x8 qp = *(bf16x8*)&w;
#pragma unroll
        for (int nn = 0; nn < 2; nn++) qc[nn] = MFMA(qp, cb[j][nn], qc[nn]);
      }
#pragma unroll
      for (int i = 0; i < 4; i++) {
        const int t = m * 16 + grp * 4 + i;
        const float wi = wiS[t];
        const float inv = 1.f / fmaxf(fabsf(denS[t]), emS[t]);
        const float hv0 = (av[0][i] + wi * qc[0][i]) * inv, hv1 = (av[1][i] + wi * qc[1][i]) * inv;
        hreg[m][i] = pack2(hv0, hv1);
        float s2 = hv0 * hv0 + hv1 * hv1;
        s2 = row16_sum(s2);
        if (col == 0) ssqS[wave * 64 + t] = s2;
      }
    }
    lds_barrier();
    {
      u32 obv[4][4];
      float gh[2];
#pragma unroll
      for (int nn = 0; nn < 2; nn++) gh[nn] = p.g_head[h * 128 + 32 * wave + 16 * nn + colL];
#pragma unroll
      for (int m = 0; m < 4; m++)
#pragma unroll
        for (int i = 0; i < 4; i++) {
          const int t = m * 16 + grpL * 4 + i;
          const u16* zp = Z + (size_t)(r0 + min(t, L - 1)) * ZLD + 3072 + h * 128 + 32 * wave + colL;
          obv[m][i] = (u32)zp[0] | ((u32)zp[16] << 16);
        }
#pragma unroll
      for (int m = 0; m < 4; m++)
#pragma unroll
        for (int i = 0; i < 4; i++) {
          const int t = m * 16 + grpL * 4 + i;
          if (t < L) {
            const float tot = ssqS[t] + ssqS[64 + t] + ssqS[128 + t] + ssqS[192 + t];
            const float r = rsqrtf(tot * (1.f / 128.f) + 1e-6f);
#pragma unroll
            for (int nn = 0; nn < 2; nn++) {
              const int vd = 32 * wave + 16 * nn + colL;
              const float o = (nn ? hi16(hreg[m][i]) : lo16(hreg[m][i])) * r * gh[nn] * sigmoidf_(nn ? hi16(obv[m][i]) : lo16(obv[m][i]));
              Z[(size_t)(r0 + t) * ZLD + 2560 + h * 128 + vd] = f2bf(o);
            }
          }
        }
    }
    if (MODE == 0) {
    const float a0 = misc[1];
#pragma unroll
    for (int mt = 0; mt < 8; mt++)
#pragma unroll
      for (int nn = 0; nn < 2; nn++)
#pragma unroll
        for (int i = 0; i < 4; i++) Cst[mt][nn][i] *= a0;
#pragma unroll
    for (int ks = 0; ks < 2; ks++)
#pragma unroll
      for (int nn = 0; nn < 2; nn++) {
        bf16x8 vb = *(const bf16x8*)(VTs + (32 * wave + 16 * nn + col) * 72 + ks * 32 + grp * 8);
#pragma unroll
        for (int mt = 0; mt < 8; mt++) {
          bf16x8 ka = *(const bf16x8*)(KTs + (mt * 16 + col) * 72 + ks * 32 + grp * 8);
          Cst[mt][nn] = MFMA(ka, vb, Cst[mt][nn]);
        }
      }
    if (tid < 128) {
      float acc = 0.f;
#pragma unroll
      for (int s8 = 0; s8 < 8; s8++) {
        uint4 v = *(const uint4*)(KTs + tid * 72 + s8 * 8);
        acc += lo16(v.x) + hi16(v.x) + lo16(v.y) + hi16(v.y) + lo16(v.z) + hi16(v.z) + lo16(v.w) + hi16(v.w);
      }
      nS[tid] = a0 * nS[tid] + acc;
    }
    if (tid == 0) misc[0] = misc[2];
    }
  }
  lds_barrier();
  if (MODE == 1) return;
  int obase = grp * 512 + 32 * wave + col;
  asm volatile("" : "+v"(obase));
#pragma unroll
  for (int mt = 0; mt < 8; mt++)
#pragma unroll
    for (int nn = 0; nn < 2; nn++)
#pragma unroll
      for (int i = 0; i < 4; i++) outC[(16 * mt + i) * 128 + 16 * nn + obase] = Cst[mt][nn][i];
  if (tid < 128) outN[tid] = nS[tid];
  if (tid == 0) *outM = misc[0];
}

__device__ __forceinline__ void mlstm_delta_item(const Params& p, int item, char* smem) {
  int tid = threadIdx.x;
  asm volatile("" : "+v"(tid));
  const int lane = tid & 63, wave = __builtin_amdgcn_readfirstlane(tid >> 6), col = lane & 15, grp = lane >> 4;
  const int wr = wave >> 1, wc = wave & 1;
  const u16* Z = (const u16*)(p.ws + OFF_Z);
  const u16* QK = (const u16*)(p.ws + OFF_H);
  const u16* VBT = (const u16*)(p.ws + OFF_VBT);
  const int bh = item >> 5, h = bh & 3;
  const int r0 = (bh >> 2) * 2048 + (item & 31) * 64;
  u16* T = (u16*)smem;
  u16* KTs = T + 128 * TLD;
  u16* VTs = KTs + 128 * 72;
  float* wsS = (float*)(VTs + 128 * 72);
  lds_barrier();
  if (wave == 0) {
    const u16* zg = Z + (size_t)(r0 + lane) * ZLD + 3584 + h;
    const u16 zi16 = zg[0], zf16 = zg[4];
    const float ig = bf2f(zi16) + p.b_if[h], zf = bf2f(zf16) + p.b_if[4 + h];
    const float lf = fminf(zf, 0.f) - log1pf(__expf(-fabsf(zf)));
    float b = lf;
#pragma unroll
    for (int o = 1; o < 64; o <<= 1) { float y = __shfl_up(b, o); if (lane >= o) b += y; }
    const float g = ig - b;
    float gm = g;
#pragma unroll
    for (int o = 32; o >= 1; o >>= 1) gm = fmaxf(gm, __shfl_xor(gm, o));
    wsS[lane] = __expf(g - gm);
    if (lane == 63) {
      float* sc = (float*)(p.ws + OFF_SCAL) + item * 4;
      sc[0] = b; sc[1] = gm;
    }
  }
  lds_barrier();
  uint4 kv[4], vv[4];
  const int s_ = tid & 63;
#pragma unroll
  for (int i = 0; i < 4; i++) {
    const int dk = (tid >> 6) + 4 * i;
    kv[i] = *(const uint4*)(QK + (size_t)(r0 + s_) * HLD + 512 + h * 128 + dk * 8);
    const int ci = tid + 256 * i;
    vv[i] = *(const uint4*)(VBT + (size_t)(h * 128 + (ci >> 3)) * VLD + r0 + (ci & 7) * 8);
  }
  const float wsv = wsS[s_];
#pragma unroll
  for (int i = 0; i < 4; i++) {
    const int dk = (tid >> 6) + 4 * i;
    const u32 w[4] = {kv[i].x, kv[i].y, kv[i].z, kv[i].w};
#pragma unroll
    for (int e = 0; e < 4; e++) {
      KTs[(dk * 8 + 2 * e) * 72 + s_] = f2bf(lo16(w[e]) * wsv);
      KTs[(dk * 8 + 2 * e + 1) * 72 + s_] = f2bf(hi16(w[e]) * wsv);
    }
    const int ci = tid + 256 * i;
    *(uint4*)(VTs + (ci >> 3) * 72 + (ci & 7) * 8) = vv[i];
  }
  lds_barrier();
  f32x4 acc[4][4];
  ACC_ZERO(acc);
#pragma unroll
  for (int ks = 0; ks < 2; ks++) {
    bf16x8 af[4], bq[4];
#pragma unroll
    for (int m = 0; m < 4; m++) af[m] = *(const bf16x8*)(VTs + (wr * 64 + m * 16 + col) * 72 + ks * 32 + grp * 8);
#pragma unroll
    for (int n = 0; n < 4; n++) bq[n] = *(const bf16x8*)(KTs + (wc * 64 + n * 16 + col) * 72 + ks * 32 + grp * 8);
#pragma unroll
    for (int m = 0; m < 4; m++)
#pragma unroll
      for (int n = 0; n < 4; n++) acc[m][n] = MFMA(af[m], bq[n], acc[m][n]);
  }
  if (tid < 128) {
    float a = 0.f;
#pragma unroll
    for (int s8 = 0; s8 < 8; s8++) {
      uint4 v = *(const uint4*)(KTs + tid * 72 + s8 * 8);
      a += lo16(v.x) + hi16(v.x) + lo16(v.y) + hi16(v.y) + lo16(v.z) + hi16(v.z) + lo16(v.w) + hi16(v.w);
    }
    ((float*)(p.ws + OFF_NBUF))[(size_t)item * 128 + tid] = a;
  }
  u16* D = (u16*)(p.ws + OFF_DELTA) + (size_t)item * 16384;
  epi_stage<false>(acc, T);
  EPI_CHUNKS(T, { *(uint4*)(D + r * 128 + c8) = v; })
}

__device__ __forceinline__ void mlstm_scan(const Params& p) {
  const int tid = threadIdx.x;
  float* SC = (float*)(p.ws + OFF_SCAL);
  for (int it = blockIdx.x; it < 256; it += gridDim.x) {
    const int bh = it >> 3, sl = it & 7;
    u16* D = (u16*)(p.ws + OFF_DELTA) + (size_t)bh * 32 * 16384 + sl * 2048 + tid * 8;
    float* NB = (float*)(p.ws + OFF_NBUF) + (size_t)bh * 32 * 128;
    float st[8], nst = 0.f, m0 = 0.f;
#pragma unroll
    for (int e = 0; e < 8; e++) st[e] = 0.f;
    const bool nrow = (sl == 0 && tid < 128);
    uint4 q0, q1, q2, q3;
    float n0 = 0.f, n1 = 0.f, n2 = 0.f, n3 = 0.f;
    float2 s0, s1, s2, s3;
#define SC_LOAD(K, Q, N, S)                                        \
  {                                                                \
    Q = *(const uint4*)(D + (size_t)(K) * 16384);                  \
    if (nrow) N = NB[(K) * 128 + tid];                             \
    S = *(const float2*)(SC + (bh * 32 + (K)) * 4);                \
  }
#define SC_STEP(C, Q, N, S)                                                                             \
  {                                                                                                     \
    uint4 o;                                                                                            \
    o.x = pack2(st[0], st[1]); o.y = pack2(st[2], st[3]); o.z = pack2(st[4], st[5]); o.w = pack2(st[6], st[7]); \
    const uint4 cur = Q; const float ncur = N; const float2 sc = S;                                     \
    *(uint4*)(D + (size_t)(C) * 16384) = o;                            \
    if (sl == 0) {                                                                                      \
      if (tid < 128) NB[(C) * 128 + tid] = nst;                                                         \
      if (tid == 0) SC[(bh * 32 + (C)) * 4 + 2] = m0;                                                   \
    }                                                                                                   \
    const float bl = sc.x, gm = sc.y;                                                                   \
    const float mx = fmaxf(m0, gm);                                                                     \
    const float al = __expf(m0 - mx), be = __expf(gm - mx);                                             \
    st[0] = al * st[0] + be * lo16(cur.x); st[1] = al * st[1] + be * hi16(cur.x);                       \
    st[2] = al * st[2] + be * lo16(cur.y); st[3] = al * st[3] + be * hi16(cur.y);                       \
    st[4] = al * st[4] + be * lo16(cur.z); st[5] = al * st[5] + be * hi16(cur.z);                       \
    st[6] = al * st[6] + be * lo16(cur.w); st[7] = al * st[7] + be * hi16(cur.w);                       \
    nst = al * nst + be * ncur;                                                                         \
    m0 = bl + mx;                                                                                       \
  }
    SC_LOAD(0, q0, n0, s0)
    SC_LOAD(1, q1, n1, s1)
    SC_LOAD(2, q2, n2, s2)
    SC_LOAD(3, q3, n3, s3)
#pragma unroll 1
    for (int c = 0; c < 32; c += 4) {
      SC_STEP(c, q0, n0, s0)
      if (c + 4 < 32) SC_LOAD(c + 4, q0, n0, s0)
      SC_STEP(c + 1, q1, n1, s1)
      if (c + 4 < 32) SC_LOAD(c + 5, q1, n1, s1)
      SC_STEP(c + 2, q2, n2, s2)
      if (c + 4 < 32) SC_LOAD(c + 6, q2, n2, s2)
      SC_STEP(c + 3, q3, n3, s3)
      if (c + 4 < 32) SC_LOAD(c + 7, q3, n3, s3)
    }
#undef SC_LOAD
#undef SC_STEP
    const int vd = sl * 16 + (tid >> 4), kd0 = (tid & 15) * 8;
    float* oc = p.out + O_PBC + (size_t)bh * 16384;
#pragma unroll
    for (int e = 0; e < 8; e++) oc[(kd0 + e) * 128 + vd] = st[e];
    if (sl == 0) {
      if (tid < 128) p.out[O_PBN + bh * 128 + tid] = nst;
      if (tid == 0) p.out[O_PBM + bh] = m0;
    }
  }
}

__device__ __forceinline__ void phase_mixers(const Params& p, char* smem, int* s_item) {
  char* ws = p.ws;
  u16* Z = (u16*)(ws + OFF_Z);
  const u16* VAT = (const u16*)(ws + OFF_VAT);
  const int tid = threadIdx.x;
  {
    const size_t gs = (size_t)gridDim.x * 256, g0 = (size_t)blockIdx.x * 256 + tid;
    for (size_t i = g0; i < 2097152; i += gs) {
      int f = i & 511; int r = (i >> 9) & 511; int b = i >> 18;
      p.out[O_PAK + i] = bf2f(Z[(size_t)(b * 2048 + 1536 + r) * ZLD + 512 + f]);
    }
    for (size_t i = g0; i < 2097152; i += gs) {
      int r = i & 511; int f = (i >> 9) & 511; int b = i >> 18;
      p.out[O_PAV + ((size_t)(b * 512 + r) * 512 + f)] = bf2f(VAT[(size_t)f * VLD + b * 2048 + 1536 + r]);
    }
    for (size_t i = g0; i < 262144; i += gs) {
      int f = i & 511; int r = i >> 9;
      p.out[O_SAK + i] = bf2f(Z[(size_t)(NP + r) * ZLD + 512 + f]);
    }
    for (size_t i = g0; i < 262144; i += gs) {
      int r = i & 511; int f = i >> 9;
      p.out[O_SAV + (size_t)r * 512 + f] = bf2f(VAT[(size_t)f * VLD + NP + r]);
    }
    for (size_t i = g0; i < 24576; i += gs) {
      int c = i & 1023; int j = (i >> 10) % 3; int b = i / 3072;
      p.out[O_PBCONV + i] = bf2f(Z[(size_t)(b * 2048 + 2045 + j) * ZLD + 1536 + c]);
    }
    for (size_t i = g0; i < 49152; i += gs) {
      int c = i & 1023; int j = (i >> 10) % 3; int sb = i / 3072;
      p.out[O_SBCONV + i] = bf2f(Z[(size_t)(NP + sb * 32 + 29 + j) * ZLD + 1536 + c]);
    }
  }
  int* ctr = (int*)(ws + OFF_CTR);
  const int total = 1088 + 2048 + 128;
  for (;;) {
    __syncthreads();
    if (tid == 0) *s_item = atomicAdd(ctr, 1);
    __syncthreads();
    const int it = __builtin_amdgcn_readfirstlane(*s_item);
    if (it >= total) break;
    if (it < 1024) {
      mlstm_delta_item(p, it, smem);
    } else if (it < 1088) {
      mlstm_item<0>(p, it - 1024, smem);
    } else if (it < 1088 + 2048) {
      const int q = it - 1088;
      const int h = q & 7, c = (q >> 3) & 31, b = q >> 8;
      const int nb = c < 8 ? c : 8;
      u16* Qp = Z + (size_t)(b * 2048 + c * 64) * ZLD + h * 64;
      auto tf = [=](int j) {
        const int cc = c - nb + j;
        AttnTile T;
        T.k = Z + (size_t)(b * 2048 + cc * 64) * ZLD + 512 + h * 64; T.ldk = ZLD;
        T.vt = VAT + (size_t)(h * 64) * VLD + b * 2048 + cc * 64; T.ldvt = VLD;
        T.nvalid = 64; T.kpos0 = cc * 64;
        return T;
      };
      attn_item<64>(Qp, ZLD, 64, Qp, ZLD, nb + 1, tf, p.rel_bias + h * 257, c * 64, 0.125f, smem);
    } else {
      const int q = it - 1088 - 2048;
      const int h = q & 7, sb = q >> 3;
      const u16* KC = (const u16*)(ws + OFF_KC);
      const u16* VCT = (const u16*)(ws + OFF_VCT);
      u16* Qp = Z + (size_t)(NP + sb * 32) * ZLD + h * 64;
      auto tf = [=](int j) {
        AttnTile T;
        if (j < 8) {
          T.k = KC + (size_t)(sb * 512 + j * 64) * 512 + h * 64; T.ldk = 512;
          T.vt = VCT + (size_t)(sb * 512 + h * 64) * 512 + j * 64; T.ldvt = 512;
          T.nvalid = 64; T.kpos0 = j * 64;
        } else {
          T.k = Z + (size_t)(NP + sb * 32) * ZLD + 512 + h * 64; T.ldk = ZLD;
          T.vt = VAT + (size_t)(h * 64) * VLD + NP + sb * 32; T.ldvt = VLD;
          T.nvalid = 32; T.kpos0 = 512;
        }
        return T;
      };
      attn_item<64>(Qp, ZLD, 32, Qp, ZLD, 9, tf, p.rel_bias + h * 257, 512, 0.125f, smem);
    }
  }
}

__device__ __forceinline__ void phase_mlstm_out(const Params& p, char* smem) {
  for (int it = blockIdx.x; it < 1024; it += gridDim.x) mlstm_item<1>(p, it, smem);
}

__device__ __forceinline__ void phase_mixed(const Params& p, char* smem) {
  char* ws = p.ws;
  const u16* Z = (const u16*)(ws + OFF_Z);
  const u16* G = (const u16*)p.out;
  u16* Hm = (u16*)(ws + OFF_H);
  const int xcd = blockIdx.x & 7, slot = blockIdx.x >> 3, nslots = gridDim.x >> 3;
#pragma unroll 1
  for (int j = slot;; j += nslots) {
    int mt, nt;
    if (!sched_tile(132, 8, xcd, j, mt, nt)) break;
    const int m0 = mt * 128, n0 = nt * 128;
    f32x4 acc[4][4];
    ACC_ZERO(acc);
    gemm_tile(Z, ZLD, (const u16*)(ws + OFF_WT_AUP), WLD5, 512, m0, n0, (u16*)smem, acc);
    {
      u16* T = (u16*)smem;
      epi_stage<false>(acc, T);
      EPI_CHUNKS(T, {
        const int row = m0 + r;
        const uint4 g = *(const uint4*)(G + (size_t)row * 2048 + ((n0 + (row & 15) * 128) & 2047) + c8);
        uint4 o;
        o.x = pack2(lo16(v.x) * sigmoidf_(lo16(g.x)), hi16(v.x) * sigmoidf_(hi16(g.x)));
        o.y = pack2(lo16(v.y) * sigmoidf_(lo16(g.y)), hi16(v.y) * sigmoidf_(hi16(g.y)));
        o.z = pack2(lo16(v.z) * sigmoidf_(lo16(g.z)), hi16(v.z) * sigmoidf_(hi16(g.z)));
        o.w = pack2(lo16(v.w) * sigmoidf_(lo16(g.w)), hi16(v.w) * sigmoidf_(hi16(g.w)));
        *(uint4*)(Hm + (size_t)row * HLD + n0 + c8) = o;
      })
    }
  }
#pragma unroll 1
  for (int j = slot;; j += nslots) {
    int mt, nt;
    if (!sched_tile(132, 8, xcd, j, mt, nt)) break;
    const int m0 = mt * 128, n0 = nt * 128;
    f32x4 acc[4][4];
    ACC_ZERO(acc);
    gemm_tile(Z + 2560, ZLD, (const u16*)(ws + OFF_WT_BUP), WLD5, 512, m0, n0, (u16*)smem, acc);
    {
      u16* T = (u16*)smem;
      epi_stage<false>(acc, T);
      EPI_CHUNKS(T, {
        const int row = m0 + r;
        const uint4 g = *(const uint4*)(G + (size_t)row * 2048 + ((1024 + n0 + (row & 15) * 128) & 2047) + c8);
        const uint4 hp = *(const uint4*)(Hm + (size_t)row * HLD + n0 + c8);
        uint4 o;
        o.x = pack2(lo16(hp.x) + lo16(v.x) * sigmoidf_(lo16(g.x)), hi16(hp.x) + hi16(v.x) * sigmoidf_(hi16(g.x)));
        o.y = pack2(lo16(hp.y) + lo16(v.y) * sigmoidf_(lo16(g.y)), hi16(hp.y) + hi16(v.y) * sigmoidf_(hi16(g.y)));
        o.z = pack2(lo16(hp.z) + lo16(v.z) * sigmoidf_(lo16(g.z)), hi16(hp.z) + hi16(v.z) * sigmoidf_(hi16(g.z)));
        o.w = pack2(lo16(hp.w) + lo16(v.w) * sigmoidf_(lo16(g.w)), hi16(hp.w) + hi16(v.w) * sigmoidf_(hi16(g.w)));
        *(uint4*)(Hm + (size_t)row * HLD + n0 + c8) = o;
      })
    }
  }
  cvt_fp8(p.peer_u, (unsigned char*)(ws + OFF_PU), 16384ull * 1024, 64.f);
  cvt_fp8(p.peer_v, (unsigned char*)(ws + OFF_PV), 16384ull * 1024, 16.f);
}

__device__ __forceinline__ void phase_gemm_generic(const Params& p, char* smem, const u16* A, const u16* Bt, int ntn, int mode, u16* dst,
                                   int ldd) {
  float* y = p.out;
  const int xcd = blockIdx.x & 7, slot = blockIdx.x >> 3, nslots = gridDim.x >> 3;
#pragma unroll 1
  for (int j = slot;; j += nslots) {
    int mt, nt;
    if (!sched_tile(132, ntn, xcd, j, mt, nt)) break;
    const int m0 = mt * 128, n0 = nt * 128;
    f32x4 acc[4][4];
    ACC_ZERO(acc);
    gemm_tile(A, HLD, Bt, HLD, 1024, m0, n0, (u16*)smem, acc);
    if (mode == 0 || mode == 1) {
      const float* xin = (mode == 1) ? y : (m0 < NP ? p.x_prompt : p.x_sample - (size_t)NP * 1024);
      _Pragma("unroll") for (int mh = 0; mh < 2; mh++) {
        float xv[2][4][4];
        EPI_LOOP(acc, m0, n0, {
          if ((m >> 1) == mh) { _Pragma("unroll") for (int j = 0; j < 4; j++) xv[m & 1][n][j] = xin[(size_t)(row + j) * 1024 + colg]; }
        })
        EPI_LOOP(acc, m0, n0, {
          if ((m >> 1) == mh) { _Pragma("unroll") for (int j = 0; j < 4; j++) y[(size_t)(row + j) * 1024 + colg] = xv[m & 1][n][j] + v[j]; }
        })
      }
    } else {
      u16* T = (u16*)smem;
      epi_stage<false>(acc, T);
      EPI_CHUNKS(T, { *(uint4*)(dst + (size_t)(m0 + r) * ldd + n0 + c8) = v; })
    }
  }
}

__device__ __forceinline__ void phase_norm(const Params& p, const float* g) {
  const int lane = threadIdx.x & 63, gw = blockIdx.x * 4 + (threadIdx.x >> 6), nw = gridDim.x * 4;
  for (int r = gw; r < NT; r += nw)
    rms_row_to_bf16(p.out + (size_t)r * 1024, g, (u16*)(p.ws + OFF_H) + (size_t)r * HLD, lane);
}

__device__ __forceinline__ void phase_cross(const Params& p, char* smem) {
  char* ws = p.ws;
  u16* QC = (u16*)(ws + OFF_QC);
  const u16* MK = (const u16*)(ws + OFF_MK);
  const u16* MVT = (const u16*)(ws + OFF_MVT);
  for (int it = blockIdx.x; it < 1024 + 64; it += gridDim.x) {
    int bb, tile, h, row0, qv;
    if (it < 1024) { h = it & 3; tile = (it >> 2) & 31; bb = it >> 7; row0 = bb * 2048 + tile * 64; qv = 64; }
    else { int q = it - 1024; h = q & 3; bb = 8 + (q >> 2); row0 = NP + (bb - 8) * 32; qv = 32; }
    u16* Qp = QC + (size_t)row0 * HLD + h * 256;
    auto tf = [=](int j) {
      AttnTile T;
      T.k = MK + (size_t)(bb * 256 + j * 64) * HLD + h * 256; T.ldk = HLD;
      T.vt = MVT + ((size_t)bb * 1024 + h * 256) * 256 + j * 64; T.ldvt = 256;
      T.nvalid = 64; T.kpos0 = 0;
      return T;
    };
    attn_item<256>(Qp, HLD, qv, Qp, HLD, 4, tf, nullptr, 0, 0.0625f, smem);
  }
}

__constant__ unsigned char STAIR[64] = {
    0x00, 0x01, 0x02, 0x03, 0x04, 0x05, 0x06, 0x07, 0x08, 0x09, 0x0A, 0x0B, 0x0C, 0x0D, 0x0E, 0x0F,
    0x10, 0x11, 0x12, 0x13, 0x14, 0x15, 0x16, 0x17,
    0x20, 0x21, 0x22, 0x23, 0x24,
    0x30, 0x31, 0x32, 0x33,
    0x40, 0x41, 0x42,
    0x50, 0x51, 0x60, 0x61, 0x70, 0x71,
    0x80, 0x90, 0xA0, 0xB0, 0xC0, 0xD0, 0xE0, 0xF0,
    0xFF, 0xFF, 0xFF, 0xFF, 0xFF, 0xFF, 0xFF, 0xFF, 0xFF, 0xFF, 0xFF, 0xFF, 0xFF, 0xFF};

#define INS16(L, x)                                                        \
  _Pragma("unroll") for (int _q = 0; _q < 16; _q++) {                       \
    const u32 _hi = umax2(L[_q], x);                                        \
    x = L[_q] < x ? L[_q] : x;                                              \
    L[_q] = _hi;                                                            \
  }
__device__ __forceinline__ void phase_route(const Params& p, char* smem) {
  char* ws = p.ws;
  const u16* PQ = (const u16*)(ws + OFF_PQ);
  const u16* SUBK = (const u16*)(ws + OFF_SUBK);
  float2* ROUTE = (float2*)(ws + OFF_ROUTE);
  int tid = threadIdx.x;
  asm volatile("" : "+v"(tid));
  const int lane = tid & 63, wave = __builtin_amdgcn_readfirstlane(tid >> 6), col = lane & 15, grp = lane >> 4;
  u16* keyS = (u16*)smem;
  u32* listS = (u32*)smem;
  u32* stairS = (u32*)(smem + 66560);
  int* cntS = (int*)(smem + 66560 + 256);
  if (tid < 64) stairS[tid] = STAIR[tid];
#pragma unroll 1
  for (int it = blockIdx.x; it < NT / 16; it += gridDim.x) {
    const int tok0 = it * 16;
    __syncthreads();
#pragma unroll 1
    for (int q = 0; q < 4; q++) {
      const int hc = wave * 4 + q;
      f32x4 acc[8];
#pragma unroll
      for (int nt = 0; nt < 8; nt++) acc[nt] = f32x4{0.f, 0.f, 0.f, 0.f};
#pragma unroll
      for (int ks = 0; ks < 4; ks++) {
        bf16x8 a = *(const bf16x8*)(PQ + (size_t)(tok0 + col) * PQLD + hc * 128 + ks * 32 + grp * 8);
#pragma unroll
        for (int nt = 0; nt < 8; nt++) {
          bf16x8 bb = *(const bf16x8*)(SUBK + (size_t)(hc * 128 + nt * 16 + col) * 128 + ks * 32 + grp * 8);
          acc[nt] = MFMA(a, bb, acc[nt]);
        }
      }
#pragma unroll
      for (int nt = 0; nt < 8; nt++)
#pragma unroll
        for (int i = 0; i < 4; i++)
          keyS[((grp * 4 + i) * 16 + hc) * 130 + nt * 16 + col] = (u16)(ordk(acc[nt][i]) >> 16);
    }
    __syncthreads();
    u32 L[16];
#pragma unroll
    for (int q = 0; q < 16; q++) L[q] = 0u;
    {
      const u32* rowp = (const u32*)(keyS + tid * 130);
#pragma unroll 4
      for (int j2 = 0; j2 < 64; j2++) {
        const u32 w = rowp[j2];
        u32 x0 = (w << 16) | (u32)(127 - 2 * j2);
        u32 x1 = (w & 0xffff0000u) | (u32)(126 - 2 * j2);
        INS16(L, x0)
        INS16(L, x1)
      }
    }
    __syncthreads();
#pragma unroll
    for (int q = 0; q < 4; q++)
      *(uint4*)(listS + tid * 16 + q * 4) = make_uint4(L[4 * q], L[4 * q + 1], L[4 * q + 2], L[4 * q + 3]);
    __syncthreads();
    int eidx[16];
    float gate[16];
    if (tid < 128) {
      const int token = tid >> 3, head = tid & 7;
      const u32* la = listS + (token * 16 + head * 2) * 16;
      const u32* lb = la + 16;
      float av[16], bv[16];
#pragma unroll
      for (int q = 0; q < 4; q++) {
        const uint4 wa = *(const uint4*)(la + 4 * q), wb = *(const uint4*)(lb + 4 * q);
        av[4 * q] = unordk(wa.x & 0xffff0000u); av[4 * q + 1] = unordk(wa.y & 0xffff0000u);
        av[4 * q + 2] = unordk(wa.z & 0xffff0000u); av[4 * q + 3] = unordk(wa.w & 0xffff0000u);
        bv[4 * q] = unordk(wb.x & 0xffff0000u); bv[4 * q + 1] = unordk(wb.y & 0xffff0000u);
        bv[4 * q + 2] = unordk(wb.z & 0xffff0000u); bv[4 * q + 3] = unordk(wb.w & 0xffff0000u);
      }
      u32 T[16];
#pragma unroll
      for (int q = 0; q < 16; q++) T[q] = 0u;
      {
        int slot = 0;
#pragma unroll
        for (int ia = 0; ia < 16; ia++)
#pragma unroll
          for (int ib = 0; ib < 16; ib++)
            if ((ia + 1) * (ib + 1) <= 16) {
              u32 x = (ordk(av[ia] + bv[ib]) & ~63u) | (u32)(63 - slot);
              INS16(T, x)
              slot++;
            }
      }
      float e[16], ssum = 0.f;
      const float vmax = unordk(T[0] & ~63u);
#pragma unroll
      for (int k = 0; k < 16; k++) { e[k] = __expf(unordk(T[k] & ~63u) - vmax); ssum += e[k]; }
      const float rs = __builtin_amdgcn_rcpf(ssum);
#pragma unroll
      for (int k = 0; k < 16; k++) {
        const u32 code = stairS[63 - (int)(T[k] & 63u)];
        const int ia = 127 - (int)(la[(code >> 4) & 15] & 127u), ib = 127 - (int)(lb[code & 15] & 127u);
        eidx[k] = ia * 128 + ib;
        gate[k] = e[k] * rs;
      }
#pragma unroll
      for (int b = 0; b < 8; b++) {
        int c = 0;
#pragma unroll
        for (int k = 0; k < 16; k++) c += ((eidx[k] >> 11) == b) ? 1 : 0;
        cntS[(token * 8 + head) * 8 + b] = c;
      }
    }
    __syncthreads();
    if (tid < 128) {
      const int token = tid >> 3, head = tid & 7;
      int base[8];
      {
        int run = 0;
#pragma unroll
        for (int b = 0; b < 8; b++) {
          int mine = 0, tot = 0;
#pragma unroll
          for (int hh = 0; hh < 8; hh++) {
            const int c = cntS[(token * 8 + hh) * 8 + b];
            mine += (hh < head) ? c : 0;
            tot += c;
          }
          base[b] = run + mine;
          run += tot;
        }
      }
      float2* ro = ROUTE + (size_t)(tok0 + token) * 128;
#pragma unroll
      for (int k = 0; k < 16; k++) {
        const int bk = eidx[k] >> 11;
        int pos = 0;
#pragma unroll
        for (int b = 0; b < 8; b++) pos += (bk == b) ? base[b] : 0;
#pragma unroll
        for (int k2 = 0; k2 < 16; k2++)
          if (k2 < k) pos += ((eidx[k2] >> 11) == bk) ? 1 : 0;
        ro[pos] = make_float2(gate[k], __int_as_float(eidx[k]));
      }
    }
  }
}
#undef INS16

__device__ __forceinline__ void unpack8(uint4 w, float* f) {
  f[0] = lo16(w.x); f[1] = hi16(w.x); f[2] = lo16(w.y); f[3] = hi16(w.y);
  f[4] = lo16(w.z); f[5] = hi16(w.z); f[6] = lo16(w.w); f[7] = hi16(w.w);
}

__device__ __forceinline__ void unpack_fp8x16(uint4 w, float* f) {
  typedef float f2_ __attribute__((ext_vector_type(2)));
  f2_ t;
  t = __builtin_amdgcn_cvt_pk_f32_fp8((int)w.x, false); f[0] = t.x; f[1] = t.y;
  t = __builtin_amdgcn_cvt_pk_f32_fp8((int)w.x, true); f[2] = t.x; f[3] = t.y;
  t = __builtin_amdgcn_cvt_pk_f32_fp8((int)w.y, false); f[4] = t.x; f[5] = t.y;
  t = __builtin_amdgcn_cvt_pk_f32_fp8((int)w.y, true); f[6] = t.x; f[7] = t.y;
  t = __builtin_amdgcn_cvt_pk_f32_fp8((int)w.z, false); f[8] = t.x; f[9] = t.y;
  t = __builtin_amdgcn_cvt_pk_f32_fp8((int)w.z, true); f[10] = t.x; f[11] = t.y;
  t = __builtin_amdgcn_cvt_pk_f32_fp8((int)w.w, false); f[12] = t.x; f[13] = t.y;
  t = __builtin_amdgcn_cvt_pk_f32_fp8((int)w.w, true); f[14] = t.x; f[15] = t.y;
}

__device__ __forceinline__ void phase_peer(const Params& p) {
  char* ws = p.ws;
  const unsigned char* PU = (const unsigned char*)(ws + OFF_PU);
  const unsigned char* PV = (const unsigned char*)(ws + OFF_PV);
  const u16* Hf = (const u16*)(ws + OFF_H);
  const float2* ROUTE = (const float2*)(ws + OFF_ROUTE);
  const int lane = threadIdx.x & 63;
  const int gw = blockIdx.x * 4 + (threadIdx.x >> 6), nw = gridDim.x * 4;
#pragma unroll 1
  for (int tk = gw; tk < NT; tk += nw) {
    float xf[16], o[16];
    unpack8(*(const uint4*)(Hf + (size_t)tk * HLD + lane * 16), xf);
    unpack8(*(const uint4*)(Hf + (size_t)tk * HLD + lane * 16 + 8), xf + 8);
#pragma unroll
    for (int j = 0; j < 16; j++) o[j] = 0.f;
    const float2* rt = ROUTE + (size_t)tk * 128;
    float2 rA[4], rB[4];
    uint4 uA[4], vA[4], uB[4], vB[4];
#define PLOAD(R, U, V, E)                                                        \
  _Pragma("unroll") for (int q = 0; q < 4; q++) {                                \
    R[q] = rt[(E) + q];                                                          \
    const size_t off = (size_t)__float_as_int(R[q].y) * 1024 + lane * 16;        \
    U[q] = *(const uint4*)(PU + off);                                            \
    V[q] = *(const uint4*)(PV + off);                                            \
  }
#define PCOMP(R, U, V)                                                           \
  _Pragma("unroll") for (int q = 0; q < 4; q++) {                                \
    float uf[16];                                                                \
    unpack_fp8x16(U[q], uf);                                                     \
    float d = 0.f;                                                               \
    _Pragma("unroll") for (int j = 0; j < 16; j++) d += uf[j] * xf[j];           \
    d = wave_sum(d) * (1.f / 64.f);                                              \
    const float act = 0.5f * d * (1.f + erff(d * 0.70710678118654752f));         \
    const float cf = R[q].x * act * (1.f / 16.f);                                \
    float vf[16];                                                                \
    unpack_fp8x16(V[q], vf);                                                     \
    _Pragma("unroll") for (int j = 0; j < 16; j++) o[j] += cf * vf[j];           \
  }
    PLOAD(rA, uA, vA, 0)
#pragma unroll 1
    for (int e = 0; e < 128; e += 8) {
      PLOAD(rB, uB, vB, e + 4)
      PCOMP(rA, uA, vA)
      if (e + 8 < 128) { PLOAD(rA, uA, vA, e + 8) }
      PCOMP(rB, uB, vB)
    }
#undef PLOAD
#undef PCOMP
    float* yr = p.out + (size_t)tk * 1024 + lane * 16;
    float4 x0 = *(const float4*)(yr), x1 = *(const float4*)(yr + 4), x2 = *(const float4*)(yr + 8), x3 = *(const float4*)(yr + 12);
    o[0] += x0.x; o[1] += x0.y; o[2] += x0.z; o[3] += x0.w; o[4] += x1.x; o[5] += x1.y; o[6] += x1.z; o[7] += x1.w;
    o[8] += x2.x; o[9] += x2.y; o[10] += x2.z; o[11] += x2.w; o[12] += x3.x; o[13] += x3.y; o[14] += x3.z; o[15] += x3.w;
    float ss = 0.f;
#pragma unroll
    for (int j = 0; j < 16; j++) ss += o[j] * o[j];
    ss = wave_sum(ss);
    const float rr = rsqrtf(ss * (1.f / 1024.f) + 1e-6f);
    const float* gf = p.g_final + lane * 16;
    float4 g0 = *(const float4*)(gf), g1 = *(const float4*)(gf + 4), g2 = *(const float4*)(gf + 8), g3 = *(const float4*)(gf + 12);
    *(float4*)(yr) = make_float4(o[0] * rr * g0.x, o[1] * rr * g0.y, o[2] * rr * g0.z, o[3] * rr * g0.w);
    *(float4*)(yr + 4) = make_float4(o[4] * rr * g1.x, o[5] * rr * g1.y, o[6] * rr * g1.z, o[7] * rr * g1.w);
    *(float4*)(yr + 8) = make_float4(o[8] * rr * g2.x, o[9] * rr * g2.y, o[10] * rr * g2.z, o[11] * rr * g2.w);
    *(float4*)(yr + 12) = make_float4(o[12] * rr * g3.x, o[13] * rr * g3.y, o[14] * rr * g3.z, o[15] * rr * g3.w);
  }
}

#define XB_TMO      128
#define XB_XCNT(j)  (256  + 64 * (j))
#define XB_XSUB(j)  (1280 + 64 * (j))
#define XB_XGEN(j)  (2304 + 64 * (j))
#define XB_TOP      3328
#define XB_TOPGEN   3392
#define XCD_BAR_WORDS 3456
#define XB_SPIN_CAP (1u << 18)
#define LAS __attribute__((address_space(3)))
__device__ __forceinline__ unsigned xb_ld(unsigned* p) { return __hip_atomic_load(p, __ATOMIC_RELAXED, __HIP_MEMORY_SCOPE_AGENT); }
__device__ __forceinline__ unsigned xb_add(unsigned* p, unsigned v) { return __hip_atomic_fetch_add(p, v, __ATOMIC_RELAXED, __HIP_MEMORY_SCOPE_AGENT); }
__device__ __forceinline__ unsigned xb_xcc_id() { return (unsigned)__builtin_amdgcn_s_getreg((3 << 11) | 20) & 0xFu; }
#define XB_SPIN(cond, bar) do { unsigned _sp = 0; while (cond) { __builtin_amdgcn_s_sleep(1); \
    if ((++_sp & 255u) == 0u) { if (xb_ld(&(bar)[XB_TMO])) break; if (_sp > XB_SPIN_CAP) { atomicAdd(&(bar)[XB_TMO], 1u); break; } } } } while (0)
struct XcdBarrier { unsigned* bar; unsigned x; volatile LAS unsigned* st; };
__device__ __forceinline__ XcdBarrier xcd_barrier_post(unsigned* bar, volatile LAS unsigned* st) {
  XcdBarrier b; b.bar = bar; b.x = xb_xcc_id(); b.st = st;
  if (threadIdx.x == 0) (void)xb_add(&bar[XB_XCNT(b.x)], 1u);
  return b;
}
__device__ __forceinline__ void xcd_barrier_complete(unsigned* bar, unsigned x, unsigned& nloc, unsigned& nx) {
  const unsigned G = gridDim.x * gridDim.y * gridDim.z;
  unsigned sum, cnt, mine, sp = 0u;
  for (;;) {
    sum = 0u; cnt = 0u; mine = 0u;
#pragma unroll
    for (unsigned j = 0; j < 16; ++j) { const unsigned c = xb_ld(&bar[XB_XCNT(j)]); sum += c; cnt += (c > 0u) ? 1u : 0u; mine = (j == x) ? c : mine; }
    if (sum == G) break;
    __builtin_amdgcn_s_sleep(1);
    if ((++sp & 255u) == 0u) { if (xb_ld(&bar[XB_TMO])) break; if (sp > XB_SPIN_CAP) { atomicAdd(&bar[XB_TMO], 1u); break; } }
  }
  nloc = mine > 0u ? mine : 1u; nx = cnt > 0u ? cnt : 1u;
}
__device__ __forceinline__ void xcd_barrier(unsigned* bbar, unsigned bx, volatile LAS unsigned* bst) {
  asm volatile("s_waitcnt vmcnt(0)" ::: "memory");
  __syncthreads();
  if (threadIdx.x == 0) {
    unsigned* bar = bbar;
    __builtin_amdgcn_s_waitcnt(0);
    unsigned nloc = bst[0], nx = bst[1];
    if (nloc == 0u) { xcd_barrier_complete(bar, bx, nloc, nx); bst[0] = nloc; bst[1] = nx; }
    const unsigned old = xb_add(&bar[XB_XSUB(bx)], 1u);
    const unsigned gen = old / nloc;
    if (old + 1u == (gen + 1u) * nloc) {
      __builtin_amdgcn_fence(__ATOMIC_RELEASE, "agent");
      asm volatile("s_waitcnt vmcnt(0)" ::: "memory");
      const unsigned og = xb_add(&bar[XB_TOP], 1u);
      const unsigned tg = og / nx;
      if (og + 1u == (tg + 1u) * nx) xb_add(&bar[XB_TOPGEN], 1u);
      else XB_SPIN(xb_ld(&bar[XB_TOPGEN]) == tg, bar);
      __builtin_amdgcn_fence(__ATOMIC_ACQUIRE, "agent");
      xb_add(&bar[XB_XGEN(bx)], 1u);
      asm volatile("s_waitcnt vmcnt(0)" ::: "memory");
    } else {
      XB_SPIN(xb_ld(&bar[XB_XGEN(bx)]) == gen, bar);
      __builtin_amdgcn_fence(__ATOMIC_ACQUIRE, "agent");
      asm volatile("s_waitcnt vmcnt(0)" ::: "memory");
    }
  }
  __syncthreads();
}

__global__ void __launch_bounds__(256, 2) fwd_kernel(Params pk) {
  __shared__ __attribute__((aligned(16))) char smem[SMEM_BYTES];
  __shared__ int s_item;
  __shared__ uint4 xb_words;
  if (threadIdx.x == 0) xb_words = make_uint4(0u, 0u, 0u, 0u);
  __syncthreads();
  unsigned* const xb_bar = (unsigned*)(pk.ws + OFF_BAR);
  volatile LAS unsigned* const xb_st = (volatile LAS unsigned*)&xb_words;
  const unsigned xb_x = xb_xcc_id();
  if (threadIdx.x == 0) (void)xb_add(&xb_bar[XB_XCNT(xb_x)], 1u);
#ifdef ONLY_PHASE
#define RUN(PH, ...) if (PH == ONLY_PHASE) { const Params& p = pk; char* ws = p.ws; (void)ws; __VA_ARGS__; }
#else
typedef const Params __attribute__((address_space(4))) * KParamsPtr;
#if defined(__HIP_DEVICE_COMPILE__)
#define LOAD_PARAMS                                                                   \
  KParamsPtr kp_ = (KParamsPtr)__builtin_amdgcn_kernarg_segment_ptr();                \
  asm volatile("" : "+s"(kp_));                                                       \
  const Params p = *kp_;
#else
#define LOAD_PARAMS const Params p = pk;
#endif
#define RUN(PH, ...)                                   \
  if (pk.ph0 <= PH && PH < pk.ph1) {                   \
    {                                                  \
      LOAD_PARAMS                                      \
      char* ws = p.ws;                                 \
      (void)ws;                                        \
      __VA_ARGS__;                                     \
    }                                                  \
    if (PH + 1 < pk.ph1) xcd_barrier(xb_bar, xb_x, xb_st); \
  }
#endif
  RUN(0, phase_prep(p, smem))
  RUN(1, phase_gemm_in(p, smem))
  RUN(2, phase_conv(p))
  RUN(3, phase_mixers(p, smem, &s_item))
  RUN(4, mlstm_scan(p))
  RUN(5, phase_mlstm_out(p, smem))
  RUN(6, phase_mixed(p, smem))
  RUN(7, phase_gemm_generic(p, smem, (const u16*)(ws + OFF_H), (const u16*)(ws + OFF_WT_OUT), 8, 0, nullptr, 0))
  RUN(8, phase_norm(p, p.g_cross))
  RUN(9, phase_gemm_generic(p, smem, (const u16*)(ws + OFF_H), (const u16*)(ws + OFF_WT_CQ), 8, 2, (u16*)(ws + OFF_QC), HLD))
  RUN(10, phase_cross(p, smem))
  RUN(11, phase_gemm_generic(p, smem, (const u16*)(ws + OFF_QC), (const u16*)(ws + OFF_WT_CO), 8, 1, nullptr, 0))
  RUN(12, phase_norm(p, p.g_ffn))
  RUN(13, phase_gemm_generic(p, smem, (const u16*)(ws + OFF_H), (const u16*)(ws + OFF_WT_PQ), 16, 2, (u16*)(ws + OFF_PQ), PQLD))
  RUN(14, phase_route(p, smem))
  RUN(15, phase_peer(p))
  if (pk.ph0 < 0) cg::this_grid().sync();
}

extern "C" void kernel_launch(void* const* d_in, const int* in_sizes, int n_in, void* d_out, int out_size, void* d_ws,
                              size_t ws_size, hipStream_t stream) {
  static int grid_blocks = 0;
  static int cus = 0;
  if (!cus) {
    int dev = 0;
    (void)hipGetDevice(&dev);
    (void)hipDeviceGetAttribute(&cus, hipDeviceAttributeMultiprocessorCount, dev);
    if (cus <= 0) cus = 256;
  }
  Params p;
  memset(&p, 0, sizeof(p));
  const float** f = (const float**)&p;
  for (int i = 0; i < 33; i++) f[i] = (const float*)d_in[i];
  p.out = (float*)d_out;
  p.ws = (char*)d_ws;
#if COOP
  p.ph0 = 0; p.ph1 = NPHASE;
  void* args[] = {&p};
  (void)hipMemsetAsync((char*)d_ws + OFF_BAR, 0, XCD_BAR_WORDS * 4, stream);
  if (!grid_blocks) {
    hipError_t e = hipLaunchCooperativeKernel((void*)fwd_kernel, dim3(2 * cus), dim3(256), args, 0, stream);
    if (e == hipSuccess) { grid_blocks = 2 * cus; return; }
    (void)hipGetLastError();
    grid_blocks = cus;
  }
  hipError_t e = hipLaunchCooperativeKernel((void*)fwd_kernel, dim3(grid_blocks), dim3(256), args, 0, stream);
  if (e != hipSuccess) fprintf(stderr, "cooperative launch failed: %s (grid %d)\n", hipGetErrorString(e), grid_blocks);
#else
  for (int ph = 0; ph < NPHASE; ph++) {
    p.ph0 = ph; p.ph1 = ph + 1;
    hipLaunchKernelGGL(fwd_kernel, dim3(2 * cus), dim3(256), 0, stream, p);
  }
#endif
}
```

```cpp
#include <hip/hip_runtime.h>
#include <hip/hip_cooperative_groups.h>
#include <cstdio>
#include <cstring>
namespace cg = cooperative_groups;

#ifndef COOP
#define COOP 1
#endif

typedef unsigned short u16;
typedef unsigned int u32;
typedef __attribute__((ext_vector_type(8))) short bf16x8;
typedef __attribute__((ext_vector_type(4))) float f32x4;
#define MFMA(a, b, c) __builtin_amdgcn_mfma_f32_16x16x32_bf16(a, b, c, 0, 0, 0)

constexpr int NT = 16896;
constexpr int NP = 16384;
constexpr int ZLD = 3712;
constexpr int NPHASE = 16;
constexpr int HLD = 1152;
constexpr int WLD5 = 640;
constexpr int PQLD = 2176;
constexpr int VLD = 17024;

constexpr size_t OFF_WT_IN = 0;
constexpr size_t OFF_WT_AUP = OFF_WT_IN + 5760ull * HLD * 2;
constexpr size_t OFF_WT_BUP = OFF_WT_AUP + 1024ull * WLD5 * 2;
constexpr size_t OFF_WT_OUT = OFF_WT_BUP + 1024ull * WLD5 * 2;
constexpr size_t OFF_WT_MKV = OFF_WT_OUT + 1024ull * HLD * 2;
constexpr size_t OFF_WT_CQ = OFF_WT_MKV + 2048ull * HLD * 2;
constexpr size_t OFF_WT_CO = OFF_WT_CQ + 1024ull * HLD * 2;
constexpr size_t OFF_WT_PQ = OFF_WT_CO + 1024ull * HLD * 2;
constexpr size_t OFF_SUBK = OFF_WT_PQ + 2048ull * HLD * 2;
constexpr size_t OFF_CTR = OFF_SUBK + 262144ull * 2;
constexpr size_t OFF_P = OFF_CTR + 4096;
constexpr size_t OFF_PU = OFF_P;
constexpr size_t OFF_PV = OFF_P + 16384ull * 1024;
constexpr size_t OFF_ROUTE = OFF_P + 2ull * 16384 * 1024;
constexpr size_t OFF_KC = OFF_P;
constexpr size_t OFF_VCT = OFF_KC + 16ull * 512 * 512 * 2;
constexpr size_t OFF_VAT = OFF_VCT + 16ull * 512 * 512 * 2;
constexpr size_t OFF_VBT = OFF_VAT + 512ull * VLD * 2;
constexpr size_t OFF_MN = OFF_VBT + 512ull * VLD * 2;
constexpr size_t OFF_H = OFF_P + 2ull * 16384 * 1024 * 2;
constexpr size_t OFF_Z = OFF_H + (size_t)NT * HLD * 2;
constexpr size_t OFF_QC = OFF_Z;
constexpr size_t OFF_PQ = OFF_Z + (size_t)NT * HLD * 2;
constexpr size_t OFF_MK = OFF_Z + (size_t)NT * ZLD * 2;
constexpr size_t OFF_MVT = OFF_MK + 6144ull * HLD * 2;
constexpr size_t OFF_DELTA = OFF_MVT + 6144ull * 1024 * 2;
constexpr size_t OFF_NBUF = OFF_DELTA + 1024ull * 16384 * 2;
constexpr size_t OFF_SCAL = OFF_NBUF + 1024ull * 128 * 4;
constexpr size_t OFF_BAR = OFF_SCAL + 1024ull * 4 * 4;
constexpr size_t WS_END = OFF_BAR + 16384;
static_assert(OFF_MN + 2048ull * HLD * 2 <= OFF_H, "early scratch overflows peer region");
static_assert(OFF_ROUTE + (size_t)NT * 128 * 8 <= OFF_H, "route overflows peer region");
static_assert(OFF_PQ + (size_t)NT * PQLD * 2 <= OFF_MK, "pq overflows z region");
static_assert(WS_END <= 336ull * 1000 * 1000, "workspace budget");

constexpr size_t O_Y = 0;
constexpr size_t O_PAK = (size_t)NT * 1024;
constexpr size_t O_PAV = O_PAK + 2097152;
constexpr size_t O_PBCONV = O_PAV + 2097152;
constexpr size_t O_PBC = O_PBCONV + 24576;
constexpr size_t O_PBN = O_PBC + 524288;
constexpr size_t O_PBM = O_PBN + 4096;
constexpr size_t O_PMK = O_PBM + 32;
constexpr size_t O_PMV = O_PMK + 2097152;
constexpr size_t O_SAK = O_PMV + 2097152;
constexpr size_t O_SAV = O_SAK + 262144;
constexpr size_t O_SBCONV = O_SAV + 262144;
constexpr size_t O_SBC = O_SBCONV + 49152;
constexpr size_t O_SBN = O_SBC + 1048576;
constexpr size_t O_SBM = O_SBN + 8192;

constexpr int SMEM_BYTES = 79872;

struct Params {
  const float *x_prompt, *x_sample, *mem_prompt, *cache_a_k, *cache_a_v, *state_b_conv, *state_b_C, *state_b_n,
      *state_b_m, *cache_mem_k, *cache_mem_v;
  const float *g_mix, *w_in, *conv_w, *conv_b, *b_if, *g_head, *rel_bias, *w_a_up, *w_b_up, *w_out, *g_mem, *w_mk,
      *w_mv, *g_cross, *w_cq, *w_co, *g_ffn, *w_pq, *sub_keys, *peer_u, *peer_v, *g_final;
  float* out;
  char* ws;
  int ph0, ph1;
};

__device__ __forceinline__ float bf2f(u16 h) { return __uint_as_float(((u32)h) << 16); }
__device__ __forceinline__ u32 pack2(float lo, float hi) {
  u32 r;
  asm("v_cvt_pk_bf16_f32 %0,%1,%2" : "=v"(r) : "v"(lo), "v"(hi));
  return r;
}
__device__ __forceinline__ u16 f2bf(float f) { return (u16)(pack2(f, 0.f) & 0xffffu); }
__device__ __forceinline__ float lo16(u32 w) { return __uint_as_float(w << 16); }
__device__ __forceinline__ float hi16(u32 w) { return __uint_as_float(w & 0xffff0000u); }

template <int CTRL>
__device__ __forceinline__ float dppf(float v) {
  return __int_as_float(__builtin_amdgcn_update_dpp(0, __float_as_int(v), CTRL, 0xF, 0xF, true));
}
template <int CTRL>
__device__ __forceinline__ u32 dppu(u32 v) {
  return (u32)__builtin_amdgcn_update_dpp(0, (int)v, CTRL, 0xF, 0xF, true);
}
__device__ __forceinline__ float row16_sum(float v) {
  v += dppf<0xB1>(v); v += dppf<0x4E>(v); v += dppf<0x141>(v); v += dppf<0x140>(v);
  return v;
}
__device__ __forceinline__ float row16_max(float v) {
  v = fmaxf(v, dppf<0xB1>(v)); v = fmaxf(v, dppf<0x4E>(v)); v = fmaxf(v, dppf<0x141>(v)); v = fmaxf(v, dppf<0x140>(v));
  return v;
}
__device__ __forceinline__ u32 umax2(u32 a, u32 b) { return a > b ? a : b; }
__device__ __forceinline__ u32 row16_umax(u32 v) {
  v = umax2(v, dppu<0xB1>(v)); v = umax2(v, dppu<0x4E>(v)); v = umax2(v, dppu<0x141>(v)); v = umax2(v, dppu<0x140>(v));
  return v;
}
__device__ __forceinline__ float wave_sum(float v) {
  v = row16_sum(v);
  v += __shfl_xor(v, 16);
  v += __shfl_xor(v, 32);
  return v;
}
__device__ __forceinline__ u32 ordk(float f) {
  u32 u = __float_as_uint(f);
  return u ^ ((u32)((int)u >> 31) | 0x80000000u);
}
__device__ __forceinline__ float unordk(u32 k) { return __uint_as_float(k ^ ((~(u32)((int)k >> 31)) | 0x80000000u)); }
__device__ __forceinline__ float sigmoidf_(float x) { return __builtin_amdgcn_rcpf(1.f + __expf(-x)); }
__device__ __forceinline__ uint4 zero4() { return make_uint4(0, 0, 0, 0); }

__device__ __forceinline__ void transpose_tile(const float* __restrict__ src, int src_ld, int k0, int c0, int col_lim,
                               u16* __restrict__ dst, int dst_ld, int dst_r0, float* tile) {
  const int tid = threadIdx.x, c = tid & 63, r4 = tid >> 6;
  {
    float tv[16];
    const int cc0 = c < col_lim ? c : 0;
#pragma unroll
    for (int i = 0; i < 16; i++) tv[i] = src[(size_t)(k0 + r4 + 4 * i) * src_ld + c0 + cc0];
#pragma unroll
    for (int i = 0; i < 16; i++) tile[(r4 + 4 * i) * 65 + c] = (c < col_lim) ? tv[i] : 0.f;
  }
  __syncthreads();
#pragma unroll 4
  for (int i = 0; i < 16; i++) {
    int cc = r4 + 4 * i;
    dst[(size_t)(dst_r0 + cc) * dst_ld + k0 + c] = f2bf(tile[c * 65 + cc]);
  }
  __syncthreads();
}

__device__ __forceinline__ void rms_row_to_bf16(const float* __restrict__ src, const float* __restrict__ g,
                                                u16* __restrict__ dst, int lane) {
  float4 v[4];
  float ss = 0.f;
#pragma unroll
  for (int i = 0; i < 4; i++) {
    v[i] = ((const float4*)src)[lane + 64 * i];
    ss += v[i].x * v[i].x + v[i].y * v[i].y + v[i].z * v[i].z + v[i].w * v[i].w;
  }
  ss = wave_sum(ss);
  float r = rsqrtf(ss * (1.f / 1024.f) + 1e-6f);
#pragma unroll
  for (int i = 0; i < 4; i++) {
    float4 gg = ((const float4*)g)[lane + 64 * i];
    uint2 o;
    o.x = pack2(v[i].x * r * gg.x, v[i].y * r * gg.y);
    o.y = pack2(v[i].z * r * gg.z, v[i].w * r * gg.w);
    ((uint2*)dst)[lane + 64 * i] = o;
  }
}

__device__ __forceinline__ void cvt_bf16(const float* __restrict__ src, u16* __restrict__ dst, size_t n) {
  size_t n8 = n >> 3;
  for (size_t i = (size_t)blockIdx.x * 256 + threadIdx.x; i < n8; i += (size_t)gridDim.x * 256) {
    float4 a = ((const float4*)src)[2 * i], b = ((const float4*)src)[2 * i + 1];
    uint4 o;
    o.x = pack2(a.x, a.y); o.y = pack2(a.z, a.w); o.z = pack2(b.x, b.y); o.w = pack2(b.z, b.w);
    ((uint4*)dst)[i] = o;
  }
}

__device__ __forceinline__ void cvt_fp8(const float* __restrict__ src, unsigned char* __restrict__ dst, size_t n, float scale) {
  size_t n16 = n >> 4;
  for (size_t i = (size_t)blockIdx.x * 256 + threadIdx.x; i < n16; i += (size_t)gridDim.x * 256) {
    const float4* sp = (const float4*)src + 4 * i;
    float4 a = sp[0], b = sp[1], c = sp[2], d = sp[3];
    int w0 = 0, w1 = 0, w2 = 0, w3 = 0;
    w0 = __builtin_amdgcn_cvt_pk_fp8_f32(a.x * scale, a.y * scale, w0, false);
    w0 = __builtin_amdgcn_cvt_pk_fp8_f32(a.z * scale, a.w * scale, w0, true);
    w1 = __builtin_amdgcn_cvt_pk_fp8_f32(b.x * scale, b.y * scale, w1, false);
    w1 = __builtin_amdgcn_cvt_pk_fp8_f32(b.z * scale, b.w * scale, w1, true);
    w2 = __builtin_amdgcn_cvt_pk_fp8_f32(c.x * scale, c.y * scale, w2, false);
    w2 = __builtin_amdgcn_cvt_pk_fp8_f32(c.z * scale, c.w * scale, w2, true);
    w3 = __builtin_amdgcn_cvt_pk_fp8_f32(d.x * scale, d.y * scale, w3, false);
    w3 = __builtin_amdgcn_cvt_pk_fp8_f32(d.z * scale, d.w * scale, w3, true);
    *(uint4*)(dst + (i >> 6) * 2048 + (i & 63) * 16) = make_uint4((u32)w0, (u32)w1, (u32)w2, (u32)w3);
  }
}

__device__ __forceinline__ void phase_prep(const Params& p, char* smem) {
  float* tile = (float*)smem;
  char* ws = p.ws;
  if (blockIdx.x == 0 && threadIdx.x < 16) ((int*)(ws + OFF_CTR))[threadIdx.x] = 0;
  for (int j = blockIdx.x; j < 5536; j += gridDim.x) {
    if (j < 928) { int kt = j & 15, nt = j >> 4;
      transpose_tile(p.w_in, 5640, kt * 64, nt * 64, 3592 - nt * 64, (u16*)(ws + OFF_WT_IN), HLD, nt * 64, tile);
    } else if (j < 1440) { int q = j - 928; int kt = q & 15, nt = q >> 4;
      transpose_tile(p.w_in, 5640, kt * 64, 3592 + nt * 64, 64, (u16*)(ws + OFF_WT_IN), HLD, 3712 + nt * 64, tile);
    } else if (j < 1568) { int q = j - 1440; int kt = q & 7, nt = q >> 3;
      transpose_tile(p.w_a_up, 1024, kt * 64, nt * 64, 64, (u16*)(ws + OFF_WT_AUP), WLD5, nt * 64, tile);
    } else if (j < 1696) { int q = j - 1568; int kt = q & 7, nt = q >> 3;
      transpose_tile(p.w_b_up, 1024, kt * 64, nt * 64, 64, (u16*)(ws + OFF_WT_BUP), WLD5, nt * 64, tile);
    } else if (j < 1952) { int q = j - 1696; int kt = q & 15, nt = q >> 4;
      transpose_tile(p.w_out, 1024, kt * 64, nt * 64, 64, (u16*)(ws + OFF_WT_OUT), HLD, nt * 64, tile);
    } else if (j < 2208) { int q = j - 1952; int kt = q & 15, nt = q >> 4;
      transpose_tile(p.w_mk, 1024, kt * 64, nt * 64, 64, (u16*)(ws + OFF_WT_MKV), HLD, nt * 64, tile);
    } else if (j < 2464) { int q = j - 2208; int kt = q & 15, nt = q >> 4;
      transpose_tile(p.w_mv, 1024, kt * 64, nt * 64, 64, (u16*)(ws + OFF_WT_MKV), HLD, 1024 + nt * 64, tile);
    } else if (j < 2720) { int q = j - 2464; int kt = q & 15, nt = q >> 4;
      transpose_tile(p.w_cq, 1024, kt * 64, nt * 64, 64, (u16*)(ws + OFF_WT_CQ), HLD, nt * 64, tile);
    } else if (j < 2976) { int q = j - 2720; int kt = q & 15, nt = q >> 4;
      transpose_tile(p.w_co, 1024, kt * 64, nt * 64, 64, (u16*)(ws + OFF_WT_CO), HLD, nt * 64, tile);
    } else if (j < 3488) { int q = j - 2976; int kt = q & 15, nt = q >> 4;
      transpose_tile(p.w_pq, 2048, kt * 64, nt * 64, 64, (u16*)(ws + OFF_WT_PQ), HLD, nt * 64, tile);
    } else if (j < 4512) { int q = j - 3488; int kt = q & 7, nt = (q >> 3) & 7, sb = q >> 6;
      transpose_tile(p.cache_a_v + (size_t)sb * 512 * 512, 512, kt * 64, nt * 64, 64,
                     (u16*)(ws + OFF_VCT) + (size_t)sb * 512 * 512, 512, nt * 64, tile);
    } else { int q = j - 4512; int kt = q & 3, nt = (q >> 2) & 15, sb = q >> 6;
      transpose_tile(p.cache_mem_v + (size_t)sb * 256 * 1024, 1024, kt * 64, nt * 64, 64,
                     (u16*)(ws + OFF_MVT) + (size_t)(8 + sb) * 1024 * 256, 256, nt * 64, tile);
    }
  }
  const int lane = threadIdx.x & 63, gw = blockIdx.x * 4 + (threadIdx.x >> 6), nw = gridDim.x * 4;
  for (int r = gw; r < NT + 2048; r += nw) {
    if (r < NP) rms_row_to_bf16(p.x_prompt + (size_t)r * 1024, p.g_mix, (u16*)(ws + OFF_H) + (size_t)r * HLD, lane);
    else if (r < NT) rms_row_to_bf16(p.x_sample + (size_t)(r - NP) * 1024, p.g_mix, (u16*)(ws + OFF_H) + (size_t)r * HLD, lane);
    else rms_row_to_bf16(p.mem_prompt + (size_t)(r - NT) * 1024, p.g_mem, (u16*)(ws + OFF_MN) + (size_t)(r - NT) * HLD, lane);
  }
  cvt_bf16(p.cache_a_k, (u16*)(ws + OFF_KC), 16ull * 512 * 512);
  {
    u16* MKs = (u16*)(ws + OFF_MK) + 2048ull * HLD;
    for (size_t i = (size_t)blockIdx.x * 256 + threadIdx.x; i < 4096ull * 128; i += (size_t)gridDim.x * 256) {
      const size_t r = i >> 7, c8 = (i & 127) * 8;
      const float4 a = *(const float4*)(p.cache_mem_k + r * 1024 + c8), b = *(const float4*)(p.cache_mem_k + r * 1024 + c8 + 4);
      uint4 o;
      o.x = pack2(a.x, a.y); o.y = pack2(a.z, a.w); o.z = pack2(b.x, b.y); o.w = pack2(b.z, b.w);
      *(uint4*)(MKs + r * HLD + c8) = o;
    }
  }
  cvt_bf16(p.sub_keys, (u16*)(ws + OFF_SUBK), 262144);
}

__device__ __forceinline__ void lds_barrier() {
  asm volatile("s_waitcnt lgkmcnt(0)" ::: "memory");
  __builtin_amdgcn_s_barrier();
  asm volatile("" ::: "memory");
}

__device__ __forceinline__ void gemm_tile(const u16* __restrict__ A, int lda, const u16* __restrict__ Bt, int ldb, int K,
                                          int m0, int n0, u16* smem, f32x4 (&acc)[4][4]) {
  int tid = threadIdx.x;
  asm volatile("" : "+v"(tid));
  const int lane = tid & 63, wave = tid >> 6;
  const int wr = wave >> 1, wc = wave & 1, col = lane & 15, grp = lane >> 4;
  const int c4 = lane & 3, r1 = (lane >> 2) & 1, half = (lane >> 3) & 1, r2 = lane >> 4;
  const int lrow = wave * 8 + r2 * 2 + r1;
  char* As = (char*)smem;
  char* Bs = As + 2 * 16384;
  int wofs;
  {
    const int ob = (lrow & 15) * 64 + c4 * 16;
    wofs = ((lrow >> 4) * 2 + half) * 1024 + (ob ^ (((ob >> 9) & 1) << 5));
  }
  int rofs;
  {
    const int ob = col * 64 + grp * 16;
    rofs = ob ^ (((ob >> 9) & 1) << 5);
  }
  const int aofs = rofs + wr * 8192, bofs = rofs + wc * 8192;
  const u16* Ag = A + (size_t)(m0 + lrow) * lda + half * 32 + c4 * 8;
  const u16* Bg = Bt + (size_t)(n0 + lrow) * ldb + half * 32 + c4 * 8;
  uint4 r0a0, r0a1, r0a2, r0a3, r0b0, r0b1, r0b2, r0b3;
  uint4 r1a0, r1a1, r1a2, r1a3, r1b0, r1b1, r1b2, r1b3;
#define G_LOAD(S, KO)                                                                               \
  S##a0 = *(const uint4*)(Ag + (KO)); S##a1 = *(const uint4*)(Ag + (size_t)32 * lda + (KO));         \
  S##a2 = *(const uint4*)(Ag + (size_t)64 * lda + (KO)); S##a3 = *(const uint4*)(Ag + (size_t)96 * lda + (KO)); \
  S##b0 = *(const uint4*)(Bg + (KO)); S##b1 = *(const uint4*)(Bg + (size_t)32 * ldb + (KO));         \
  S##b2 = *(const uint4*)(Bg + (size_t)64 * ldb + (KO)); S##b3 = *(const uint4*)(Bg + (size_t)96 * ldb + (KO));
#define G_STORE(S, AP, BP)                                                                           \
  *(uint4*)((AP) + wofs) = S##a0; *(uint4*)((AP) + wofs + 4096) = S##a1;                             \
  *(uint4*)((AP) + wofs + 8192) = S##a2; *(uint4*)((AP) + wofs + 12288) = S##a3;                     \
  *(uint4*)((BP) + wofs) = S##b0; *(uint4*)((BP) + wofs + 4096) = S##b1;                             \
  *(uint4*)((BP) + wofs + 8192) = S##b2; *(uint4*)((BP) + wofs + 12288) = S##b3;
#define G_COMPUTE(CUR)                                                                               \
  {                                                                                                  \
    const char* Ac = As + (CUR) * 16384 + aofs;                                                      \
    const char* Bc = Bs + (CUR) * 16384 + bofs;                                                      \
    _Pragma("unroll") for (int ks = 0; ks < 2; ks++) {                                               \
      bf16x8 af0, af1, af2, af3, bq0, bq1, bq2, bq3;                                                 \
      af0 = *(const bf16x8*)(Ac + 0 * 2048 + ks * 1024);                                             \
      af1 = *(const bf16x8*)(Ac + 1 * 2048 + ks * 1024);                                             \
      af2 = *(const bf16x8*)(Ac + 2 * 2048 + ks * 1024);                                             \
      af3 = *(const bf16x8*)(Ac + 3 * 2048 + ks * 1024);                                             \
      bq0 = *(const bf16x8*)(Bc + 0 * 2048 + ks * 1024);                                             \
      bq1 = *(const bf16x8*)(Bc + 1 * 2048 + ks * 1024);                                             \
      bq2 = *(const bf16x8*)(Bc + 2 * 2048 + ks * 1024);                                             \
      bq3 = *(const bf16x8*)(Bc + 3 * 2048 + ks * 1024);                                             \
      acc[0][0] = MFMA(af0, bq0, acc[0][0]); acc[0][1] = MFMA(af0, bq1, acc[0][1]);                  \
      acc[0][2] = MFMA(af0, bq2, acc[0][2]); acc[0][3] = MFMA(af0, bq3, acc[0][3]);                  \
      acc[1][0] = MFMA(af1, bq0, acc[1][0]); acc[1][1] = MFMA(af1, bq1, acc[1][1]);                  \
      acc[1][2] = MFMA(af1, bq2, acc[1][2]); acc[1][3] = MFMA(af1, bq3, acc[1][3]);                  \
      acc[2][0] = MFMA(af2, bq0, acc[2][0]); acc[2][1] = MFMA(af2, bq1, acc[2][1]);                  \
      acc[2][2] = MFMA(af2, bq2, acc[2][2]); acc[2][3] = MFMA(af2, bq3, acc[2][3]);                  \
      acc[3][0] = MFMA(af3, bq0, acc[3][0]); acc[3][1] = MFMA(af3, bq1, acc[3][1]);                  \
      acc[3][2] = MFMA(af3, bq2, acc[3][2]); acc[3][3] = MFMA(af3, bq3, acc[3][3]);                  \
    }                                                                                                \
  }
#define G_STEP(KT, SS)                                                       \
  {                                                                          \
    __builtin_amdgcn_s_setprio(1);                                           \
    G_COMPUTE((KT) & 1)                                                      \
    __builtin_amdgcn_s_setprio(0);                                           \
    G_STORE(SS, As + (((KT) + 1) & 1) * 16384, Bs + (((KT) + 1) & 1) * 16384) \
    { const int kn = min((KT) + 3, nk - 1) * 64; G_LOAD(SS, kn) }            \
    lds_barrier();                                                           \
  }
  const int nk = K >> 6;
  G_LOAD(r0, 0)
  G_LOAD(r1, 64)
  G_STORE(r0, As, Bs)
  G_LOAD(r0, 128)
  lds_barrier();
#pragma unroll 1
  for (int kt = 0; kt < nk; kt += 2) {
    G_STEP(kt, r1)
    G_STEP(kt + 1, r0)
  }
  lds_barrier();
#undef G_LOAD
#undef G_STORE
#undef G_COMPUTE
#undef G_STEP
}

__device__ __forceinline__ bool sched_tile(int NTM, int NTN, int xcd, int j, int& mt, int& nt) {
  const int mb = (NTM * xcd) >> 3, me = (NTM * (xcd + 1)) >> 3, nm = me - mb;
  if (j >= nm * NTN) return false;
  const int nfull = nm >> 3, fullcnt = nfull * 8 * NTN;
  if (j < fullcnt) {
    const int mg = j / (8 * NTN), r = j - mg * 8 * NTN;
    nt = r >> 3; mt = mb + mg * 8 + (r & 7);
  } else {
    const int r = j - fullcnt, gsz = nm - nfull * 8;
    nt = r / gsz; mt = mb + nfull * 8 + (r - nt * gsz);
  }
  return true;
}

constexpr int TLD = 136;
template <bool TR>
__device__ __forceinline__ void epi_stage(f32x4 (&acc)[4][4], u16* T) {
  int lane = threadIdx.x & 63;
  asm volatile("" : "+v"(lane));
  const int wave = threadIdx.x >> 6, wr = wave >> 1, wc = wave & 1, col = lane & 15, grp = lane >> 4;
#pragma unroll
  for (int m = 0; m < 4; m++)
#pragma unroll
    for (int n = 0; n < 4; n++) {
      const int r = wr * 64 + m * 16 + grp * 4, c = wc * 64 + n * 16 + col;
      if (TR) {
        uint2 o; o.x = pack2(acc[m][n][0], acc[m][n][1]); o.y = pack2(acc[m][n][2], acc[m][n][3]);
        *(uint2*)(T + c * TLD + r) = o;
      } else {
#pragma unroll
        for (int j = 0; j < 4; j++) T[(r + j) * TLD + c] = f2bf(acc[m][n][j]);
      }
    }
  lds_barrier();
}
#define EPI_CHUNKS(T, ...)                                              \
  {                                                                     \
    int _t = threadIdx.x;                                               \
    asm volatile("" : "+v"(_t));                                        \
    _Pragma("unroll") for (int _i = 0; _i < 8; _i++) {                  \
      const int _ch = _t + 256 * _i;                                    \
      const int r = _ch >> 4, c8 = (_ch & 15) * 8;                      \
      const uint4 v = *(const uint4*)((T) + r * TLD + c8);              \
      __VA_ARGS__                                                       \
    }                                                                   \
    lds_barrier();                                                      \
  }

#define ACC_ZERO(acc)                                   \
  _Pragma("unroll") for (int m = 0; m < 4; m++)          \
  _Pragma("unroll") for (int n = 0; n < 4; n++) acc[m][n] = f32x4{0.f, 0.f, 0.f, 0.f};

#define EPI_LOOP(acc, m0, n0, ...)                                                               \
  {                                                                                              \
    int _lane = threadIdx.x & 63; const int _wave = threadIdx.x >> 6;                            \
    asm volatile("" : "+v"(_lane));                                                            \
    const int _wr = _wave >> 1, _wc = _wave & 1;                                                 \
    _Pragma("unroll") for (int m = 0; m < 4; m++) _Pragma("unroll") for (int n = 0; n < 4; n++) { \
      const int row = (m0) + _wr * 64 + m * 16 + (_lane >> 4) * 4;                               \
      const int colg = (n0) + _wc * 64 + n * 16 + (_lane & 15);                                  \
      f32x4 v = acc[m][n];                                                                       \
      __VA_ARGS__                                                                                \
    }                                                                                            \
  }

__device__ __forceinline__ void phase_gemm_in(const Params& p, char* smem) {
  char* ws = p.ws;
  const u16* H = (const u16*)(ws + OFF_H);
  u16* Z = (u16*)(ws + OFF_Z);
  u16* VAT = (u16*)(ws + OFF_VAT);
  u16* VBT = (u16*)(ws + OFF_VBT);
  u16* G = (u16*)(p.out);
  const int xcd = blockIdx.x & 7, slot = blockIdx.x >> 3, nslots = gridDim.x >> 3;
  for (int pass = 0; pass < 2; pass++)
  for (int j = slot;; j += nslots) {
    int mt, nt;
    if (!sched_tile(pass == 0 ? 132 : 16, pass == 0 ? 45 : 16, xcd, j, mt, nt)) break;
    f32x4 acc[4][4];
    ACC_ZERO(acc);
    if (pass == 0) {
      const int m0 = mt * 128, n0 = nt * 128;
      gemm_tile(H, HLD, (const u16*)(ws + OFF_WT_IN), HLD, 1024, m0, n0, (u16*)smem, acc);
      u16* T = (u16*)smem;
      if (nt >= 29) {
        epi_stage<false>(acc, T);
        const int ng = n0 - 3712;
        EPI_CHUNKS(T, {
          const int row = m0 + r;
          *(uint4*)(G + (size_t)row * 2048 + ((ng + (row & 15) * 128) & 2047) + c8) = v;
        })
      } else if (nt >= 8 && nt < 12) {
        epi_stage<true>(acc, T);
        EPI_CHUNKS(T, { *(uint4*)(VAT + (size_t)(n0 - 1024 + r) * VLD + m0 + c8) = v; })
      } else if (nt >= 20 && nt < 24) {
        epi_stage<true>(acc, T);
        EPI_CHUNKS(T, { *(uint4*)(VBT + (size_t)(n0 - 2560 + r) * VLD + m0 + c8) = v; })
      } else {
        epi_stage<false>(acc, T);
        EPI_CHUNKS(T, { *(uint4*)(Z + (size_t)(m0 + r) * ZLD + n0 + c8) = v; })
      }
    } else {
      const int m0 = mt * 128, n0 = nt * 128;
      gemm_tile((const u16*)(ws + OFF_MN), HLD, (const u16*)(ws + OFF_WT_MKV), HLD, 1024, m0, n0, (u16*)smem, acc);
      if (nt < 8) {
        u16* MK = (u16*)(ws + OFF_MK);
        float* o = p.out + O_PMK;
        EPI_LOOP(acc, m0, n0, {
          _Pragma("unroll") for (int j = 0; j < 4; j++) {
            o[(size_t)(row + j) * 1024 + colg] = v[j];
            MK[(size_t)(row + j) * HLD + colg] = f2bf(v[j]);
          }
        })
      } else {
        u16* MVT = (u16*)(ws + OFF_MVT);
        float* o = p.out + O_PMV;
        EPI_LOOP(acc, m0, n0 - 1024, {
          _Pragma("unroll") for (int j = 0; j < 4; j++) o[(size_t)(row + j) * 1024 + colg] = v[j];
          uint2 w; w.x = pack2(v[0], v[1]); w.y = pack2(v[2], v[3]);
          const int b = row >> 8, mm = row & 255;
          *(uint2*)(MVT + ((size_t)b * 1024 + colg) * 256 + mm) = w;
        })
      }
    }
  }
}

__device__ __forceinline__ void phase_conv(const Params& p) {
  const u16* Z = (const u16*)(p.ws + OFF_Z);
  u16* QK = (u16*)(p.ws + OFF_H);
  for (int idx = blockIdx.x * 256 + threadIdx.x; idx < NT * 128; idx += gridDim.x * 256) {
    const int row = idx >> 7, c0 = (idx & 127) * 8;
    const bool samp = row >= NP;
    const int t = samp ? ((row - NP) & 31) : (row & 2047);
    const int sb = (row - NP) >> 5;
    float acc[8];
    {
      float4 b0 = *(const float4*)(p.conv_b + c0), b1 = *(const float4*)(p.conv_b + c0 + 4);
      acc[0] = b0.x; acc[1] = b0.y; acc[2] = b0.z; acc[3] = b0.w; acc[4] = b1.x; acc[5] = b1.y; acc[6] = b1.z; acc[7] = b1.w;
    }
    uint4 zw[4];
#pragma unroll
    for (int d = 0; d < 4; d++) zw[d] = *(const uint4*)(Z + (size_t)(row - min(d, t)) * ZLD + 1536 + c0);
#pragma unroll
    for (int d = 0; d < 4; d++) {
      float u[8];
      const uint4 w = zw[d];
      u[0] = lo16(w.x); u[1] = hi16(w.x); u[2] = lo16(w.y); u[3] = hi16(w.y);
      u[4] = lo16(w.z); u[5] = hi16(w.z); u[6] = lo16(w.w); u[7] = hi16(w.w);
      if (t - d < 0) {
        if (samp) {
          const float* pr = p.state_b_conv + (size_t)(sb * 3 + (3 + t - d)) * 1024 + c0;
          float4 a = *(const float4*)pr, b = *(const float4*)(pr + 4);
          u[0] = a.x; u[1] = a.y; u[2] = a.z; u[3] = a.w; u[4] = b.x; u[5] = b.y; u[6] = b.z; u[7] = b.w;
        } else {
#pragma unroll
          for (int e = 0; e < 8; e++) u[e] = 0.f;
        }
      }
      const float* wp = p.conv_w + (3 - d) * 1024 + c0;
      float4 w0 = *(const float4*)wp, w1 = *(const float4*)(wp + 4);
      acc[0] += u[0] * w0.x; acc[1] += u[1] * w0.y; acc[2] += u[2] * w0.z; acc[3] += u[3] * w0.w;
      acc[4] += u[4] * w1.x; acc[5] += u[5] * w1.y; acc[6] += u[6] * w1.z; acc[7] += u[7] * w1.w;
    }
    const float sc = (c0 >= 512) ? 0.08838834764831845f : 1.f;
#pragma unroll
    for (int e = 0; e < 8; e++) acc[e] = acc[e] * sigmoidf_(acc[e]) * sc;
    uint4 o;
    o.x = pack2(acc[0], acc[1]); o.y = pack2(acc[2], acc[3]); o.z = pack2(acc[4], acc[5]); o.w = pack2(acc[6], acc[7]);
    *(uint4*)(QK + (size_t)row * HLD + c0) = o;
  }
}

struct AttnTile { const u16* k; int ldk; const u16* vt; int ldvt; int nvalid; int kpos0; };

template <int DH, class TileFn>
__device__ __forceinline__ void attn_item(const u16* __restrict__ Q, int ldq, int qvalid, u16* __restrict__ O, int ldo, int ntiles,
                          TileFn tf, const float* __restrict__ biasG, int qpos0, float scale, char* smem) {
  constexpr int KLD = DH + 8, NKS = DH / 32, NDT = DH / 16, CPT = DH / 32;
  u16* Ks = (u16*)smem;
  u16* VTs = Ks + 64 * KLD;
  u16* Ps = VTs + DH * 72;
  float* biasS = (float*)(Ps + 4 * 16 * 72);
  int tid = threadIdx.x;
  asm volatile("" : "+v"(tid));
  const int lane = tid & 63, wave = tid >> 6, col = lane & 15, grp = lane >> 4;
  const float L2E = 1.4426950408889634f;
  bf16x8 qf[NKS];
  {
    const int qr = wave * 16 + col;
    const bool ok = qr < qvalid;
#pragma unroll
    for (int ks = 0; ks < NKS; ks++) {
      uint4 w = ok ? *(const uint4*)(Q + (size_t)qr * ldq + ks * 32 + grp * 8) : zero4();
      qf[ks] = *(bf16x8*)&w;
    }
  }
  lds_barrier();
  if (biasG) for (int i = tid; i < 257; i += 256) biasS[i] = biasG[i];
  f32x4 oacc[NDT];
#pragma unroll
  for (int i = 0; i < NDT; i++) oacc[i] = f32x4{0.f, 0.f, 0.f, 0.f};
  float mrun[4], lrun[4];
#pragma unroll
  for (int i = 0; i < 4; i++) { mrun[i] = -INFINITY; lrun[i] = 0.f; }
  uint4 pk_[CPT], pv_[CPT];
  if (DH == 64) {
    const AttnTile T0 = tf(0);
    const int n01 = T0.nvalid - 1;
#pragma unroll
    for (int i = 0; i < CPT; i++) {
      const int c = tid + 256 * i;
      const int key = c / (DH / 8), dc = c % (DH / 8);
      pk_[i] = *(const uint4*)(T0.k + (size_t)min(key, n01) * T0.ldk + dc * 8);
      const int d = c >> 3, kc = c & 7;
      pv_[i] = *(const uint4*)(T0.vt + (size_t)d * T0.ldvt + min(kc * 8, (n01 >> 3) * 8));
    }
  }
#pragma unroll 1
  for (int j = 0; j < ntiles; j++) {
    AttnTile T = tf(j);
    int tidL = tid;
    asm volatile("" : "+v"(tidL));
    lds_barrier();
    const int nvm1 = T.nvalid - 1;
    if (DH == 64) {
#pragma unroll
      for (int i = 0; i < CPT; i++) {
        const int c = tidL + 256 * i;
        const int key = c / (DH / 8), dc = c % (DH / 8);
        *(uint4*)(Ks + key * KLD + dc * 8) = key <= nvm1 ? pk_[i] : zero4();
        const int d = c >> 3, kc = c & 7;
        *(uint4*)(VTs + d * 72 + kc * 8) = (kc * 8 <= nvm1) ? pv_[i] : zero4();
      }
    } else {
      uint4 kv[CPT];
#pragma unroll
      for (int i = 0; i < CPT; i++) {
        const int c = tidL + 256 * i;
        const int key = c / (DH / 8), dc = c % (DH / 8);
        kv[i] = *(const uint4*)(T.k + (size_t)min(key, nvm1) * T.ldk + dc * 8);
      }
#pragma unroll
      for (int i = 0; i < CPT; i++) {
        const int c = tidL + 256 * i;
        const int key = c / (DH / 8), dc = c % (DH / 8);
        *(uint4*)(Ks + key * KLD + dc * 8) = key <= nvm1 ? kv[i] : zero4();
      }
#pragma unroll
      for (int i = 0; i < CPT; i++) {
        const int c = tidL + 256 * i;
        const int d = c >> 3, kc = c & 7;
        kv[i] = *(const uint4*)(T.vt + (size_t)d * T.ldvt + min(kc * 8, (nvm1 >> 3) * 8));
      }
#pragma unroll
      for (int i = 0; i < CPT; i++) {
        const int c = tidL + 256 * i;
        const int d = c >> 3, kc = c & 7;
        *(uint4*)(VTs + d * 72 + kc * 8) = (kc * 8 <= nvm1) ? kv[i] : zero4();
      }
    }
    lds_barrier();
    if (DH == 64 && j + 1 < ntiles) {
      const AttnTile Tn = tf(j + 1);
      const int nn1 = Tn.nvalid - 1;
#pragma unroll
      for (int i = 0; i < CPT; i++) {
        const int c = tidL + 256 * i;
        const int key = c / (DH / 8), dc = c % (DH / 8);
        pk_[i] = *(const uint4*)(Tn.k + (size_t)min(key, nn1) * Tn.ldk + dc * 8);
        const int d = c >> 3, kc = c & 7;
        pv_[i] = *(const uint4*)(Tn.vt + (size_t)d * Tn.ldvt + min(kc * 8, (nn1 >> 3) * 8));
      }
    }
    f32x4 s[4];
#pragma unroll
    for (int n = 0; n < 4; n++) s[n] = f32x4{0.f, 0.f, 0.f, 0.f};
#pragma unroll
    for (int ks = 0; ks < NKS; ks++)
#pragma unroll
      for (int n = 0; n < 4; n++) {
        bf16x8 kf = *(const bf16x8*)(Ks + (n * 16 + col) * KLD + ks * 32 + grp * 8);
        s[n] = MFMA(qf[ks], kf, s[n]);
      }
    float mx[4] = {-INFINITY, -INFINITY, -INFINITY, -INFINITY};
#pragma unroll
    for (int n = 0; n < 4; n++)
#pragma unroll
      for (int i = 0; i < 4; i++) {
        const int key = n * 16 + col;
        float v = s[n][i] * scale;
        if (biasG) {
          int rel = qpos0 + wave * 16 + grp * 4 + i - (T.kpos0 + key);
          rel = min(max(rel, -128), 128) + 128;
          v += biasS[rel];
        }
        if (key >= T.nvalid) v = -INFINITY;
        s[n][i] = v;
        mx[i] = fmaxf(mx[i], v);
      }
    float alpha[4], lsum[4];
#pragma unroll
    for (int i = 0; i < 4; i++) {
      float m2 = fmaxf(mrun[i], row16_max(mx[i]));
      alpha[i] = exp2f((mrun[i] - m2) * L2E);
      mrun[i] = m2;
      lsum[i] = 0.f;
    }
#pragma unroll
    for (int n = 0; n < 4; n++)
#pragma unroll
      for (int i = 0; i < 4; i++) {
        float pv = exp2f((s[n][i] - mrun[i]) * L2E);
        lsum[i] += pv;
        Ps[(wave * 16 + grp * 4 + i) * 72 + n * 16 + col] = f2bf(pv);
      }
#pragma unroll
    for (int i = 0; i < 4; i++) lrun[i] = lrun[i] * alpha[i] + lsum[i];
#pragma unroll
    for (int nd = 0; nd < NDT; nd++)
#pragma unroll
      for (int i = 0; i < 4; i++) oacc[nd][i] *= alpha[i];
    asm volatile("s_waitcnt lgkmcnt(0)" ::: "memory");
#pragma unroll
    for (int k2 = 0; k2 < 2; k2++) {
      bf16x8 pf = *(const bf16x8*)(Ps + (wave * 16 + col) * 72 + k2 * 32 + grp * 8);
#pragma unroll
      for (int nd = 0; nd < NDT; nd++) {
        bf16x8 vf = *(const bf16x8*)(VTs + (nd * 16 + col) * 72 + k2 * 32 + grp * 8);
        oacc[nd] = MFMA(pf, vf, oacc[nd]);
      }
    }
  }
  int rowb = wave * 16 + grp * 4;
  asm volatile("" : "+v"(rowb));
#pragma unroll
  for (int i = 0; i < 4; i++) {
    float l = row16_sum(lrun[i]);
    float inv = __builtin_amdgcn_rcpf(l);
    const int row = rowb + i;
    if (row < qvalid) {
#pragma unroll
      for (int nd = 0; nd < NDT; nd++) O[(size_t)row * ldo + nd * 16 + col] = f2bf(oacc[nd][i] * inv);
    }
  }
}

template <int MODE>
__device__ __forceinline__ void mlstm_item(const Params& p, int item, char* smem) {
  int tid = threadIdx.x;
  asm volatile("" : "+v"(tid));
  const int lane = tid & 63, wave = __builtin_amdgcn_readfirstlane(tid >> 6), col = lane & 15, grp = lane >> 4;
  u16* Z = (u16*)(p.ws + OFF_Z);
  const u16* QK = (const u16*)(p.ws + OFF_H);
  const u16* VBT = (const u16*)(p.ws + OFF_VBT);
  const bool sample = (MODE == 0);
  int h, L, nchunks, row0, bh;
  float *outC = nullptr, *outN = nullptr, *outM = nullptr;
  const u16* CT = nullptr;
  if (MODE == 1) {
    bh = item >> 5; h = bh & 3; L = 64; nchunks = 1; row0 = (bh >> 2) * 2048 + (item & 31) * 64;
    CT = (const u16*)(p.ws + OFF_DELTA) + (size_t)item * 16384;
  } else {
    bh = item; h = bh & 3; L = 32; nchunks = 1; row0 = NP + (bh >> 2) * 32;
    outC = p.out + O_SBC + (size_t)bh * 16384; outN = p.out + O_SBN + bh * 128; outM = p.out + O_SBM + bh;
  }
  u16* Qs = (u16*)smem;
  u16* Ks = Qs + 64 * 136;
  u16* As = Ks;
  u16* KTs = Ks + 64 * 136;
  u16* VTs = KTs + 128 * 72;
  float* fS = (float*)(VTs + 128 * 72);
  float *gS = fS, *MS = fS + 64, *wiS = fS + 128, *emS = fS + 192, *wsS = fS + 256, *denS = fS + 320,
        *ssqS = fS + 384, *nS = fS + 640, *misc = fS + 768;
  f32x4 Cst[8][2];
  const float bif_i = p.b_if[h], bif_f = p.b_if[4 + h];
  lds_barrier();
  if (MODE == 1) {
    if (tid < 128) nS[tid] = ((const float*)(p.ws + OFF_NBUF))[(size_t)item * 128 + tid];
    if (tid == 0) misc[0] = ((const float*)(p.ws + OFF_SCAL))[item * 4 + 2];
  } else if (sample) {
    const float* C0 = p.state_b_C + (size_t)bh * 16384;
    int ibase = grp * 512 + 32 * wave + col;
    asm volatile("" : "+v"(ibase));
#pragma unroll
    for (int mt = 0; mt < 8; mt++)
#pragma unroll
      for (int nn = 0; nn < 2; nn++)
#pragma unroll
        for (int i = 0; i < 4; i++) Cst[mt][nn][i] = C0[(16 * mt + i) * 128 + 16 * nn + ibase];
    if (tid < 128) nS[tid] = p.state_b_n[bh * 128 + tid];
    if (tid == 0) misc[0] = p.state_b_m[bh];
  } else {
#pragma unroll
    for (int mt = 0; mt < 8; mt++)
#pragma unroll
      for (int nn = 0; nn < 2; nn++) Cst[mt][nn] = f32x4{0.f, 0.f, 0.f, 0.f};
    if (tid < 128) nS[tid] = 0.f;
    if (tid == 0) misc[0] = 0.f;
  }
  u16 gpre_i = 0, gpre_f = 0;
  if (wave == 0) {
    const u16* zg = Z + (size_t)(row0 + min(lane, L - 1)) * ZLD + 3584 + h;
    gpre_i = zg[0]; gpre_f = zg[4];
  }
#pragma unroll 1
  for (int c = 0; c < nchunks; c++) {
    int r0 = row0 + c * 64;
    int tidL = tid, colL = col, grpL = grp;
    asm volatile("" : "+v"(r0), "+v"(tidL), "+v"(colL), "+v"(grpL));
    lds_barrier();
    if (wave == 0) {
      const int t = lane;
      float ig = -INFINITY, lf = 0.f;
      {
        const float zi = bf2f(gpre_i) + bif_i, zf = bf2f(gpre_f) + bif_f;
        if (c + 1 < nchunks) {
          const u16* zg = Z + (size_t)(r0 + 64 + t) * ZLD + 3584 + h;
          gpre_i = zg[0]; gpre_f = zg[4];
        }
        if (t < L) {
          ig = zi;
          lf = fminf(zf, 0.f) - log1pf(__expf(-fabsf(zf)));
        }
      }
      float b = lf;
#pragma unroll
      for (int o = 1; o < 64; o <<= 1) { float y = __shfl_up(b, o); if (lane >= o) b += y; }
      const float g = ig - b;
      const float m0 = misc[0];
      float M = g;
#pragma unroll
      for (int o = 1; o < 64; o <<= 1) { float y = __shfl_up(M, o); if (lane >= o) M = fmaxf(M, y); }
      M = fmaxf(M, m0);
      const float Mend = __shfl(M, 63), bl = __shfl(b, 63);
      gS[t] = g; MS[t] = M; wiS[t] = __expf(m0 - M); emS[t] = __expf(-(b + M)); wsS[t] = __expf(g - Mend);
      if (lane == 0) { misc[1] = __expf(m0 - Mend); misc[2] = bl + Mend; }
    }
    lds_barrier();
    {
      uint4 qv[4], kv[4], vv[4];
      const int Lm1 = L - 1;
      const int s_ = tidL & 63;
#pragma unroll
      for (int i = 0; i < 4; i++) {
        const int ci = tidL + 256 * i;
        const int t = ci >> 4, dc = ci & 15;
        qv[i] = *(const uint4*)(QK + (size_t)(r0 + min(t, Lm1)) * HLD + h * 128 + dc * 8);
        const int dk = (tidL >> 6) + 4 * i;
        kv[i] = *(const uint4*)(QK + (size_t)(r0 + min(s_, Lm1)) * HLD + 512 + h * 128 + dk * 8);
        const int vd = ci >> 3, sc = ci & 7;
        vv[i] = *(const uint4*)(VBT + (size_t)(h * 128 + vd) * VLD + r0 + min(sc * 8, (Lm1 >> 3) * 8));
      }
      const float wsv = wsS[s_];
#pragma unroll
      for (int i = 0; i < 4; i++) {
        const int ci = tidL + 256 * i;
        const int t = ci >> 4, dc = ci & 15;
        *(uint4*)(Qs + t * 136 + dc * 8) = t <= Lm1 ? qv[i] : zero4();
        const int dk = (tidL >> 6) + 4 * i;
        const uint4 v = s_ <= Lm1 ? kv[i] : zero4();
        *(uint4*)(Ks + s_ * 136 + dk * 8) = v;
        const u32 w[4] = {v.x, v.y, v.z, v.w};
#pragma unroll
        for (int e = 0; e < 4; e++) {
          KTs[(dk * 8 + 2 * e) * 72 + s_] = f2bf(lo16(w[e]) * wsv);
          KTs[(dk * 8 + 2 * e + 1) * 72 + s_] = f2bf(hi16(w[e]) * wsv);
        }
        const int vd = ci >> 3, sc = ci & 7;
        *(uint4*)(VTs + vd * 72 + sc * 8) = (sc * 8 <= Lm1) ? vv[i] : zero4();
      }
    }
    lds_barrier();
    f32x4 sacc[4];
#pragma unroll
    for (int n = 0; n < 4; n++) sacc[n] = f32x4{0.f, 0.f, 0.f, 0.f};
#pragma unroll
    for (int ks = 0; ks < 4; ks++) {
      bf16x8 qa = *(const bf16x8*)(Qs + (wave * 16 + col) * 136 + ks * 32 + grp * 8);
#pragma unroll
      for (int n = 0; n < 4; n++)
        if (n <= wave) {
          bf16x8 kb = *(const bf16x8*)(Ks + (n * 16 + col) * 136 + ks * 32 + grp * 8);
          sacc[n] = MFMA(qa, kb, sacc[n]);
        }
    }
#pragma unroll
    for (int n = 0; n < 4; n++)
#pragma unroll
      for (int i = 0; i < 4; i++) {
        const int t = wave * 16 + grp * 4 + i, s = n * 16 + col;
        const float dec = __expf(gS[s] - MS[t]);
        sacc[n][i] = (s <= t) ? sacc[n][i] * dec : 0.f;
      }
    lds_barrier();
#pragma unroll
    for (int n = 0; n < 4; n++)
#pragma unroll
      for (int i = 0; i < 4; i++) As[(wave * 16 + grp * 4 + i) * 72 + n * 16 + col] = f2bf(sacc[n][i]);
    lds_barrier();
    {
      f32x4 d1 = f32x4{0.f, 0.f, 0.f, 0.f}, d2 = f32x4{0.f, 0.f, 0.f, 0.f};
      const u32 one2 = (col == 0) ? 0x3F803F80u : 0u;
      uint4 ow = make_uint4(one2, one2, one2, one2);
      bf16x8 ones = *(bf16x8*)&ow;
#pragma unroll
      for (int ks = 0; ks < 2; ks++)
        if (ks == 0 || wave >= 2) {
          bf16x8 aa = *(const bf16x8*)(As + (wave * 16 + col) * 72 + ks * 32 + grp * 8);
          d1 = MFMA(aa, ones, d1);
        }
#pragma unroll
      for (int ks = 0; ks < 4; ks++) {
        uint4 w = zero4();
        if (col == 0) {
          const float* np_ = nS + ks * 32 + grp * 8;
          w.x = pack2(np_[0], np_[1]); w.y = pack2(np_[2], np_[3]); w.z = pack2(np_[4], np_[5]); w.w = pack2(np_[6], np_[7]);
        }
        bf16x8 nf = *(bf16x8*)&w;
        bf16x8 qa = *(const bf16x8*)(Qs + (wave * 16 + col) * 136 + ks * 32 + grp * 8);
        d2 = MFMA(qa, nf, d2);
      }
      if (col == 0) {
#pragma unroll
        for (int i = 0; i < 4; i++) { const int t = wave * 16 + grp * 4 + i; denS[t] = d1[i] + wiS[t] * d2[i]; }
      }
    }
    lds_barrier();
    bf16x8 cb[4][2];
#pragma unroll
    for (int j = 0; j < 4; j++)
#pragma unroll
      for (int nn = 0; nn < 2; nn++) {
        uint4 w;
        if (MODE == 1) {
          w = *(const uint4*)(CT + (size_t)(32 * wave + 16 * nn + col) * 128 + 32 * j + grp * 8);
        } else {
          w.x = pack2(Cst[2 * j][nn][0], Cst[2 * j][nn][1]);
          w.y = pack2(Cst[2 * j][nn][2], Cst[2 * j][nn][3]);
          w.z = pack2(Cst[2 * j + 1][nn][0], Cst[2 * j + 1][nn][1]);
          w.w = pack2(Cst[2 * j + 1][nn][2], Cst[2 * j + 1][nn][3]);
        }
        cb[j][nn] = *(bf16x8*)&w;
      }
    u32 hreg[4][4];
#pragma unroll
    for (int m = 0; m < 4; m++) {
      f32x4 av[2], qc[2];
#pragma unroll
      for (int nn = 0; nn < 2; nn++) { av[nn] = f32x4{0.f, 0.f, 0.f, 0.f}; qc[nn] = f32x4{0.f, 0.f, 0.f, 0.f}; }
#pragma unroll
      for (int ks = 0; ks < 2; ks++)
        if (ks == 0 || m >= 2) {
          bf16x8 aa = *(const bf16x8*)(As + (m * 16 + col) * 72 + ks * 32 + grp * 8);
#pragma unroll
          for (int nn = 0; nn < 2; nn++) {
            bf16x8 vb = *(const bf16x8*)(VTs + (32 * wave + 16 * nn + col) * 72 + ks * 32 + grp * 8);
            av[nn] = MFMA(aa, vb, av[nn]);
          }
        }
#pragma unroll
      for (int j = 0; j < 4; j++) {
        uint4 w;
        if (MODE == 1) {
          w = *(const uint4*)(Qs + (m * 16 + col) * 136 + 32 * j + 8 * grp);
        } else {
          uint2 a0 = *(const uint2*)(Qs + (m * 16 + col) * 136 + 32 * j + 4 * grp);
          uint2 a1 = *(const uint2*)(Qs + (m * 16 + col) * 136 + 32 * j + 16 + 4 * grp);
          w = make_uint4(a0.x, a0.y, a1.x, a1.y);
        }
        bf16x8 qp = *(bf16x8*)&w;
#pragma unroll
        for (int nn = 0; nn < 2; nn++) qc[nn] = MFMA(qp, cb[j][nn], qc[nn]);
      }
#pragma unroll
      for (int i = 0; i < 4; i++) {
        const int t = m * 16 + grp * 4 + i;
        const float wi = wiS[t];
        const float inv = 1.f / fmaxf(fabsf(denS[t]), emS[t]);
        const float hv0 = (av[0][i] + wi * qc[0][i]) * inv, hv1 = (av[1][i] + wi * qc[1][i]) * inv;
        hreg[m][i] = pack2(hv0, hv1);
        float s2 = hv0 * hv0 + hv1 * hv1;
        s2 = row16_sum(s2);
        if (col == 0) ssqS[wave * 64 + t] = s2;
      }
    }
    lds_barrier();
    {
      u32 obv[4][4];
      float gh[2];
#pragma unroll
      for (int nn = 0; nn < 2; nn++) gh[nn] = p.g_head[h * 128 + 32 * wave + 16 * nn + colL];
#pragma unroll
      for (int m = 0; m < 4; m++)
#pragma unroll
        for (int i = 0; i < 4; i++) {
          const int t = m * 16 + grpL * 4 + i;
          const u16* zp = Z + (size_t)(r0 + min(t, L - 1)) * ZLD + 3072 + h * 128 + 32 * wave + colL;
          obv[m][i] = (u32)zp[0] | ((u32)zp[16] << 16);
        }
#pragma unroll
      for (int m = 0; m < 4; m++)
#pragma unroll
        for (int i = 0; i < 4; i++) {
          const int t = m * 16 + grpL * 4 + i;
          if (t < L) {
            const float tot = ssqS[t] + ssqS[64 + t] + ssqS[128 + t] + ssqS[192 + t];
            const float r = rsqrtf(tot * (1.f / 128.f) + 1e-6f);
#pragma unroll
            for (int nn = 0; nn < 2; nn++) {
              const int vd = 32 * wave + 16 * nn + colL;
              const float o = (nn ? hi16(hreg[m][i]) : lo16(hreg[m][i])) * r * gh[nn] * sigmoidf_(nn ? hi16(obv[m][i]) : lo16(obv[m][i]));
              Z[(size_t)(r0 + t) * ZLD + 2560 + h * 128 + vd] = f2bf(o);
            }
          }
        }
    }
    if (MODE == 0) {
    const float a0 = misc[1];
#pragma unroll
    for (int mt = 0; mt < 8; mt++)
#pragma unroll
      for (int nn = 0; nn < 2; nn++)
#pragma unroll
        for (int i = 0; i < 4; i++) Cst[mt][nn][i] *= a0;
#pragma unroll
    for (int ks = 0; ks < 2; ks++)
#pragma unroll
      for (int nn = 0; nn < 2; nn++) {
        bf16x8 vb = *(const bf16x8*)(VTs + (32 * wave + 16 * nn + col) * 72 + ks * 32 + grp * 8);
#pragma unroll
        for (int mt = 0; mt < 8; mt++) {
          bf16x8 ka = *(const bf16x8*)(KTs + (mt * 16 + col) * 72 + ks * 32 + grp * 8);
          Cst[mt][nn] = MFMA(ka, vb, Cst[mt][nn]);
        }
      }
    if (tid < 128) {
      float acc = 0.f;
#pragma unroll
      for (int s8 = 0; s8 < 8; s8++) {
        uint4 v = *(const uint4*)(KTs + tid * 72 + s8 * 8);
        acc += lo16(v.x) + hi16(v.x) + lo16(v.y) + hi16(v.y) + lo16(v.z) + hi16(v.z) + lo16(v.w) + hi16(v.w);
      }
      nS[tid] = a0 * nS[tid] + acc;
    }
    if (tid == 0) misc[0] = misc[2];
    }
  }
  lds_barrier();
  if (MODE == 1) return;
  int obase = grp * 512 + 32 * wave + col;
  asm volatile("" : "+v"(obase));
#pragma unroll
  for (int mt = 0; mt < 8; mt++)
#pragma unroll
    for (int nn = 0; nn < 2; nn++)
#pragma unroll
      for (int i = 0; i < 4; i++) outC[(16 * mt + i) * 128 + 16 * nn + obase] = Cst[mt][nn][i];
  if (tid < 128) outN[tid] = nS[tid];
  if (tid == 0) *outM = misc[0];
}

__device__ __forceinline__ void mlstm_delta_item(const Params& p, int item, char* smem) {
  int tid = threadIdx.x;
  asm volatile("" : "+v"(tid));
  const int lane = tid & 63, wave = __builtin_amdgcn_readfirstlane(tid >> 6), col = lane & 15, grp = lane >> 4;
  const int wr = wave >> 1, wc = wave & 1;
  const u16* Z = (const u16*)(p.ws + OFF_Z);
  const u16* QK = (const u16*)(p.ws + OFF_H);
  const u16* VBT = (const u16*)(p.ws + OFF_VBT);
  const int bh = item >> 5, h = bh & 3;
  const int r0 = (bh >> 2) * 2048 + (item & 31) * 64;
  u16* T = (u16*)smem;
  u16* KTs = T + 128 * TLD;
  u16* VTs = KTs + 128 * 72;
  float* wsS = (float*)(VTs + 128 * 72);
  lds_barrier();
  if (wave == 0) {
    const u16* zg = Z + (size_t)(r0 + lane) * ZLD + 3584 + h;
    const u16 zi16 = zg[0], zf16 = zg[4];
    const float ig = bf2f(zi16) + p.b_if[h], zf = bf2f(zf16) + p.b_if[4 + h];
    const float lf = fminf(zf, 0.f) - log1pf(__expf(-fabsf(zf)));
    float b = lf;
#pragma unroll
    for (int o = 1; o < 64; o <<= 1) { float y = __shfl_up(b, o); if (lane >= o) b += y; }
    const float g = ig - b;
    float gm = g;
#pragma unroll
    for (int o = 32; o >= 1; o >>= 1) gm = fmaxf(gm, __shfl_xor(gm, o));
    wsS[lane] = __expf(g - gm);
    if (lane == 63) {
      float* sc = (float*)(p.ws + OFF_SCAL) + item * 4;
      sc[0] = b; sc[1] = gm;
    }
  }
  lds_barrier();
  uint4 kv[4], vv[4];
  const int s_ = tid & 63;
#pragma unroll
  for (int i = 0; i < 4; i++) {
    const int dk = (tid >> 6) + 4 * i;
    kv[i] = *(const uint4*)(QK + (size_t)(r0 + s_) * HLD + 512 + h * 128 + dk * 8);
    const int ci = tid + 256 * i;
    vv[i] = *(const uint4*)(VBT + (size_t)(h * 128 + (ci >> 3)) * VLD + r0 + (ci & 7) * 8);
  }
  const float wsv = wsS[s_];
#pragma unroll
  for (int i = 0; i < 4; i++) {
    const int dk = (tid >> 6) + 4 * i;
    const u32 w[4] = {kv[i].x, kv[i].y, kv[i].z, kv[i].w};
#pragma unroll
    for (int e = 0; e < 4; e++) {
      KTs[(dk * 8 + 2 * e) * 72 + s_] = f2bf(lo16(w[e]) * wsv);
      KTs[(dk * 8 + 2 * e + 1) * 72 + s_] = f2bf(hi16(w[e]) * wsv);
    }
    const int ci = tid + 256 * i;
    *(uint4*)(VTs + (ci >> 3) * 72 + (ci & 7) * 8) = vv[i];
  }
  lds_barrier();
  f32x4 acc[4][4];
  ACC_ZERO(acc);
#pragma unroll
  for (int ks = 0; ks < 2; ks++) {
    bf16x8 af[4], bq[4];
#pragma unroll
    for (int m = 0; m < 4; m++) af[m] = *(const bf16x8*)(VTs + (wr * 64 + m * 16 + col) * 72 + ks * 32 + grp * 8);
#pragma unroll
    for (int n = 0; n < 4; n++) bq[n] = *(const bf16x8*)(KTs + (wc * 64 + n * 16 + col) * 72 + ks * 32 + grp * 8);
#pragma unroll
    for (int m = 0; m < 4; m++)
#pragma unroll
      for (int n = 0; n < 4; n++) acc[m][n] = MFMA(af[m], bq[n], acc[m][n]);
  }
  if (tid < 128) {
    float a = 0.f;
#pragma unroll
    for (int s8 = 0; s8 < 8; s8++) {
      uint4 v = *(const uint4*)(KTs + tid * 72 + s8 * 8);
      a += lo16(v.x) + hi16(v.x) + lo16(v.y) + hi16(v.y) + lo16(v.z) + hi16(v.z) + lo16(v.w) + hi16(v.w);
    }
    ((float*)(p.ws + OFF_NBUF))[(size_t)item * 128 + tid] = a;
  }
  u16* D = (u16*)(p.ws + OFF_DELTA) + (size_t)item * 16384;
  epi_stage<false>(acc, T);
  EPI_CHUNKS(T, { *(uint4*)(D + r * 128 + c8) = v; })
}

__device__ __forceinline__ void mlstm_scan(const Params& p) {
  const int tid = threadIdx.x;
  float* SC = (float*)(p.ws + OFF_SCAL);
  for (int it = blockIdx.x; it < 256; it += gridDim.x) {
    const int bh = it >> 3, sl = it & 7;
    u16* D = (u16*)(p.ws + OFF_DELTA) + (size_t)bh * 32 * 16384 + sl * 2048 + tid * 8;
    float* NB = (float*)(p.ws + OFF_NBUF) + (size_t)bh * 32 * 128;
    float st[8], nst = 0.f, m0 = 0.f;
#pragma unroll
    for (int e = 0; e < 8; e++) st[e] = 0.f;
    uint4 cur = *(const uint4*)D;
    float ncur = (sl == 0 && tid < 128) ? NB[tid] : 0.f;
    float2 sc = *(const float2*)(SC + (bh * 32) * 4);
#pragma unroll 1
    for (int c = 0; c < 32; c++) {
      uint4 nxt = cur; float nnxt = ncur; float2 scn = sc;
      if (c + 1 < 32) {
        nxt = *(const uint4*)(D + (size_t)(c + 1) * 16384);
        if (sl == 0 && tid < 128) nnxt = NB[(c + 1) * 128 + tid];
        scn = *(const float2*)(SC + (bh * 32 + c + 1) * 4);
      }
      uint4 o;
      o.x = pack2(st[0], st[1]); o.y = pack2(st[2], st[3]); o.z = pack2(st[4], st[5]); o.w = pack2(st[6], st[7]);
      *(uint4*)(D + (size_t)c * 16384) = o;
      if (sl == 0) {
        if (tid < 128) NB[c * 128 + tid] = nst;
        if (tid == 0) SC[(bh * 32 + c) * 4 + 2] = m0;
      }
      const float bl = sc.x, gm = sc.y;
      const float mx = fmaxf(m0, gm);
      const float al = __expf(m0 - mx), be = __expf(gm - mx);
      st[0] = al * st[0] + be * lo16(cur.x); st[1] = al * st[1] + be * hi16(cur.x);
      st[2] = al * st[2] + be * lo16(cur.y); st[3] = al * st[3] + be * hi16(cur.y);
      st[4] = al * st[4] + be * lo16(cur.z); st[5] = al * st[5] + be * hi16(cur.z);
      st[6] = al * st[6] + be * lo16(cur.w); st[7] = al * st[7] + be * hi16(cur.w);
      nst = al * nst + be * ncur;
      m0 = bl + mx;
      cur = nxt; ncur = nnxt; sc = scn;
    }
    const int vd = sl * 16 + (tid >> 4), kd0 = (tid & 15) * 8;
    float* oc = p.out + O_PBC + (size_t)bh * 16384;
#pragma unroll
    for (int e = 0; e < 8; e++) oc[(kd0 + e) * 128 + vd] = st[e];
    if (sl == 0) {
      if (tid < 128) p.out[O_PBN + bh * 128 + tid] = nst;
      if (tid == 0) p.out[O_PBM + bh] = m0;
    }
  }
}

__device__ __forceinline__ void phase_mixers(const Params& p, char* smem, int* s_item) {
  char* ws = p.ws;
  u16* Z = (u16*)(ws + OFF_Z);
  const u16* VAT = (const u16*)(ws + OFF_VAT);
  const int tid = threadIdx.x;
  {
    const size_t gs = (size_t)gridDim.x * 256, g0 = (size_t)blockIdx.x * 256 + tid;
    for (size_t i = g0; i < 2097152; i += gs) {
      int f = i & 511; int r = (i >> 9) & 511; int b = i >> 18;
      p.out[O_PAK + i] = bf2f(Z[(size_t)(b * 2048 + 1536 + r) * ZLD + 512 + f]);
    }
    for (size_t i = g0; i < 2097152; i += gs) {
      int r = i & 511; int f = (i >> 9) & 511; int b = i >> 18;
      p.out[O_PAV + ((size_t)(b * 512 + r) * 512 + f)] = bf2f(VAT[(size_t)f * VLD + b * 2048 + 1536 + r]);
    }
    for (size_t i = g0; i < 262144; i += gs) {
      int f = i & 511; int r = i >> 9;
      p.out[O_SAK + i] = bf2f(Z[(size_t)(NP + r) * ZLD + 512 + f]);
    }
    for (size_t i = g0; i < 262144; i += gs) {
      int r = i & 511; int f = i >> 9;
      p.out[O_SAV + (size_t)r * 512 + f] = bf2f(VAT[(size_t)f * VLD + NP + r]);
    }
    for (size_t i = g0; i < 24576; i += gs) {
      int c = i & 1023; int j = (i >> 10) % 3; int b = i / 3072;
      p.out[O_PBCONV + i] = bf2f(Z[(size_t)(b * 2048 + 2045 + j) * ZLD + 1536 + c]);
    }
    for (size_t i = g0; i < 49152; i += gs) {
      int c = i & 1023; int j = (i >> 10) % 3; int sb = i / 3072;
      p.out[O_SBCONV + i] = bf2f(Z[(size_t)(NP + sb * 32 + 29 + j) * ZLD + 1536 + c]);
    }
  }
  int* ctr = (int*)(ws + OFF_CTR);
  const int total = 1088 + 2048 + 128;
  for (;;) {
    __syncthreads();
    if (tid == 0) *s_item = atomicAdd(ctr, 1);
    __syncthreads();
    const int it = __builtin_amdgcn_readfirstlane(*s_item);
    if (it >= total) break;
    if (it < 1024) {
      mlstm_delta_item(p, it, smem);
    } else if (it < 1088) {
      mlstm_item<0>(p, it - 1024, smem);
    } else if (it < 1088 + 2048) {
      const int q = it - 1088;
      const int h = q & 7, c = (q >> 3) & 31, b = q >> 8;
      const int nb = c < 8 ? c : 8;
      u16* Qp = Z + (size_t)(b * 2048 + c * 64) * ZLD + h * 64;
      auto tf = [=](int j) {
        const int cc = c - nb + j;
        AttnTile T;
        T.k = Z + (size_t)(b * 2048 + cc * 64) * ZLD + 512 + h * 64; T.ldk = ZLD;
        T.vt = VAT + (size_t)(h * 64) * VLD + b * 2048 + cc * 64; T.ldvt = VLD;
        T.nvalid = 64; T.kpos0 = cc * 64;
        return T;
      };
      attn_item<64>(Qp, ZLD, 64, Qp, ZLD, nb + 1, tf, p.rel_bias + h * 257, c * 64, 0.125f, smem);
    } else {
      const int q = it - 1088 - 2048;
      const int h = q & 7, sb = q >> 3;
      const u16* KC = (const u16*)(ws + OFF_KC);
      const u16* VCT = (const u16*)(ws + OFF_VCT);
      u16* Qp = Z + (size_t)(NP + sb * 32) * ZLD + h * 64;
      auto tf = [=](int j) {
        AttnTile T;
        if (j < 8) {
          T.k = KC + (size_t)(sb * 512 + j * 64) * 512 + h * 64; T.ldk = 512;
          T.vt = VCT + (size_t)(sb * 512 + h * 64) * 512 + j * 64; T.ldvt = 512;
          T.nvalid = 64; T.kpos0 = j * 64;
        } else {
          T.k = Z + (size_t)(NP + sb * 32) * ZLD + 512 + h * 64; T.ldk = ZLD;
          T.vt = VAT + (size_t)(h * 64) * VLD + NP + sb * 32; T.ldvt = VLD;
          T.nvalid = 32; T.kpos0 = 512;
        }
        return T;
      };
      attn_item<64>(Qp, ZLD, 32, Qp, ZLD, 9, tf, p.rel_bias + h * 257, 512, 0.125f, smem);
    }
  }
}

__device__ __forceinline__ void phase_mlstm_out(const Params& p, char* smem) {
  for (int it = blockIdx.x; it < 1024; it += gridDim.x) mlstm_item<1>(p, it, smem);
}

__device__ __forceinline__ void phase_mixed(const Params& p, char* smem) {
  char* ws = p.ws;
  const u16* Z = (const u16*)(ws + OFF_Z);
  const u16* G = (const u16*)p.out;
  u16* Hm = (u16*)(ws + OFF_H);
  const int xcd = blockIdx.x & 7, slot = blockIdx.x >> 3, nslots = gridDim.x >> 3;
#pragma unroll 1
  for (int j = slot;; j += nslots) {
    int mt, nt;
    if (!sched_tile(132, 8, xcd, j, mt, nt)) break;
    const int m0 = mt * 128, n0 = nt * 128;
    f32x4 acc[4][4];
    ACC_ZERO(acc);
    gemm_tile(Z, ZLD, (const u16*)(ws + OFF_WT_AUP), WLD5, 512, m0, n0, (u16*)smem, acc);
    {
      u16* T = (u16*)smem;
      epi_stage<false>(acc, T);
      EPI_CHUNKS(T, {
        const int row = m0 + r;
        const uint4 g = *(const uint4*)(G + (size_t)row * 2048 + ((n0 + (row & 15) * 128) & 2047) + c8);
        uint4 o;
        o.x = pack2(lo16(v.x) * sigmoidf_(lo16(g.x)), hi16(v.x) * sigmoidf_(hi16(g.x)));
        o.y = pack2(lo16(v.y) * sigmoidf_(lo16(g.y)), hi16(v.y) * sigmoidf_(hi16(g.y)));
        o.z = pack2(lo16(v.z) * sigmoidf_(lo16(g.z)), hi16(v.z) * sigmoidf_(hi16(g.z)));
        o.w = pack2(lo16(v.w) * sigmoidf_(lo16(g.w)), hi16(v.w) * sigmoidf_(hi16(g.w)));
        *(uint4*)(Hm + (size_t)row * HLD + n0 + c8) = o;
      })
    }
  }
#pragma unroll 1
  for (int j = slot;; j += nslots) {
    int mt, nt;
    if (!sched_tile(132, 8, xcd, j, mt, nt)) break;
    const int m0 = mt * 128, n0 = nt * 128;
    f32x4 acc[4][4];
    ACC_ZERO(acc);
    gemm_tile(Z + 2560, ZLD, (const u16*)(ws + OFF_WT_BUP), WLD5, 512, m0, n0, (u16*)smem, acc);
    {
      u16* T = (u16*)smem;
      epi_stage<false>(acc, T);
      EPI_CHUNKS(T, {
        const int row = m0 + r;
        const uint4 g = *(const uint4*)(G + (size_t)row * 2048 + ((1024 + n0 + (row & 15) * 128) & 2047) + c8);
        const uint4 hp = *(const uint4*)(Hm + (size_t)row * HLD + n0 + c8);
        uint4 o;
        o.x = pack2(lo16(hp.x) + lo16(v.x) * sigmoidf_(lo16(g.x)), hi16(hp.x) + hi16(v.x) * sigmoidf_(hi16(g.x)));
        o.y = pack2(lo16(hp.y) + lo16(v.y) * sigmoidf_(lo16(g.y)), hi16(hp.y) + hi16(v.y) * sigmoidf_(hi16(g.y)));
        o.z = pack2(lo16(hp.z) + lo16(v.z) * sigmoidf_(lo16(g.z)), hi16(hp.z) + hi16(v.z) * sigmoidf_(hi16(g.z)));
        o.w = pack2(lo16(hp.w) + lo16(v.w) * sigmoidf_(lo16(g.w)), hi16(hp.w) + hi16(v.w) * sigmoidf_(hi16(g.w)));
        *(uint4*)(Hm + (size_t)row * HLD + n0 + c8) = o;
      })
    }
  }
  cvt_fp8(p.peer_u, (unsigned char*)(ws + OFF_PU), 16384ull * 1024, 64.f);
  cvt_fp8(p.peer_v, (unsigned char*)(ws + OFF_PU) + 1024, 16384ull * 1024, 16.f);
}

__device__ __forceinline__ void phase_gemm_generic(const Params& p, char* smem, const u16* A, const u16* Bt, int ntn, int mode, u16* dst,
                                   int ldd) {
  float* y = p.out;
  const int xcd = blockIdx.x & 7, slot = blockIdx.x >> 3, nslots = gridDim.x >> 3;
#pragma unroll 1
  for (int j = slot;; j += nslots) {
    int mt, nt;
    if (!sched_tile(132, ntn, xcd, j, mt, nt)) break;
    const int m0 = mt * 128, n0 = nt * 128;
    f32x4 acc[4][4];
    ACC_ZERO(acc);
    gemm_tile(A, HLD, Bt, HLD, 1024, m0, n0, (u16*)smem, acc);
    if (mode == 0 || mode == 1) {
      const float* xin = (mode == 1) ? y : (m0 < NP ? p.x_prompt : p.x_sample - (size_t)NP * 1024);
      _Pragma("unroll") for (int mh = 0; mh < 2; mh++) {
        float xv[2][4][4];
        EPI_LOOP(acc, m0, n0, {
          if ((m >> 1) == mh) { _Pragma("unroll") for (int j = 0; j < 4; j++) xv[m & 1][n][j] = xin[(size_t)(row + j) * 1024 + colg]; }
        })
        EPI_LOOP(acc, m0, n0, {
          if ((m >> 1) == mh) { _Pragma("unroll") for (int j = 0; j < 4; j++) y[(size_t)(row + j) * 1024 + colg] = xv[m & 1][n][j] + v[j]; }
        })
      }
    } else {
      u16* T = (u16*)smem;
      epi_stage<false>(acc, T);
      EPI_CHUNKS(T, { *(uint4*)(dst + (size_t)(m0 + r) * ldd + n0 + c8) = v; })
    }
  }
}

__device__ __forceinline__ void phase_norm(const Params& p, const float* g) {
  const int lane = threadIdx.x & 63, gw = blockIdx.x * 4 + (threadIdx.x >> 6), nw = gridDim.x * 4;
  for (int r = gw; r < NT; r += nw)
    rms_row_to_bf16(p.out + (size_t)r * 1024, g, (u16*)(p.ws + OFF_H) + (size_t)r * HLD, lane);
}

__device__ __forceinline__ void phase_cross(const Params& p, char* smem) {
  char* ws = p.ws;
  u16* QC = (u16*)(ws + OFF_QC);
  const u16* MK = (const u16*)(ws + OFF_MK);
  const u16* MVT = (const u16*)(ws + OFF_MVT);
  for (int it = blockIdx.x; it < 1024 + 64; it += gridDim.x) {
    int bb, tile, h, row0, qv;
    if (it < 1024) { h = it & 3; tile = (it >> 2) & 31; bb = it >> 7; row0 = bb * 2048 + tile * 64; qv = 64; }
    else { int q = it - 1024; h = q & 3; bb = 8 + (q >> 2); row0 = NP + (bb - 8) * 32; qv = 32; }
    u16* Qp = QC + (size_t)row0 * HLD + h * 256;
    auto tf = [=](int j) {
      AttnTile T;
      T.k = MK + (size_t)(bb * 256 + j * 64) * HLD + h * 256; T.ldk = HLD;
      T.vt = MVT + ((size_t)bb * 1024 + h * 256) * 256 + j * 64; T.ldvt = 256;
      T.nvalid = 64; T.kpos0 = 0;
      return T;
    };
    attn_item<256>(Qp, HLD, qv, Qp, HLD, 4, tf, nullptr, 0, 0.0625f, smem);
  }
}

__constant__ unsigned char STAIR[64] = {
    0x00, 0x01, 0x02, 0x03, 0x04, 0x05, 0x06, 0x07, 0x08, 0x09, 0x0A, 0x0B, 0x0C, 0x0D, 0x0E, 0x0F,
    0x10, 0x11, 0x12, 0x13, 0x14, 0x15, 0x16, 0x17,
    0x20, 0x21, 0x22, 0x23, 0x24,
    0x30, 0x31, 0x32, 0x33,
    0x40, 0x41, 0x42,
    0x50, 0x51, 0x60, 0x61, 0x70, 0x71,
    0x80, 0x90, 0xA0, 0xB0, 0xC0, 0xD0, 0xE0, 0xF0,
    0xFF, 0xFF, 0xFF, 0xFF, 0xFF, 0xFF, 0xFF, 0xFF, 0xFF, 0xFF, 0xFF, 0xFF, 0xFF, 0xFF};

#define INS16(L, x)                                                        \
  _Pragma("unroll") for (int _q = 0; _q < 16; _q++) {                       \
    const u32 _hi = umax2(L[_q], x);                                        \
    x = L[_q] < x ? L[_q] : x;                                              \
    L[_q] = _hi;                                                            \
  }
__device__ __forceinline__ void phase_route(const Params& p, char* smem) {
  char* ws = p.ws;
  const u16* PQ = (const u16*)(ws + OFF_PQ);
  const u16* SUBK = (const u16*)(ws + OFF_SUBK);
  float2* ROUTE = (float2*)(ws + OFF_ROUTE);
  int tid = threadIdx.x;
  asm volatile("" : "+v"(tid));
  const int lane = tid & 63, wave = __builtin_amdgcn_readfirstlane(tid >> 6), col = lane & 15, grp = lane >> 4;
  u16* keyS = (u16*)smem;
  u32* listS = (u32*)smem;
  u32* stairS = (u32*)(smem + 66560);
  int* cntS = (int*)(smem + 66560 + 256);
  if (tid < 64) stairS[tid] = STAIR[tid];
#pragma unroll 1
  for (int it = blockIdx.x; it < NT / 16; it += gridDim.x) {
    const int tok0 = it * 16;
    __syncthreads();
#pragma unroll 1
    for (int q = 0; q < 4; q++) {
      const int hc = wave * 4 + q;
      f32x4 acc[8];
#pragma unroll
      for (int nt = 0; nt < 8; nt++) acc[nt] = f32x4{0.f, 0.f, 0.f, 0.f};
#pragma unroll
      for (int ks = 0; ks < 4; ks++) {
        bf16x8 a = *(const bf16x8*)(PQ + (size_t)(tok0 + col) * PQLD + hc * 128 + ks * 32 + grp * 8);
#pragma unroll
        for (int nt = 0; nt < 8; nt++) {
          bf16x8 bb = *(const bf16x8*)(SUBK + (size_t)(hc * 128 + nt * 16 + col) * 128 + ks * 32 + grp * 8);
          acc[nt] = MFMA(a, bb, acc[nt]);
        }
      }
#pragma unroll
      for (int nt = 0; nt < 8; nt++)
#pragma unroll
        for (int i = 0; i < 4; i++)
          keyS[((grp * 4 + i) * 16 + hc) * 130 + nt * 16 + col] = (u16)(ordk(acc[nt][i]) >> 16);
    }
    __syncthreads();
    u32 L[16];
#pragma unroll
    for (int q = 0; q < 16; q++) L[q] = 0u;
    {
      const u32* rowp = (const u32*)(keyS + tid * 130);
#pragma unroll 4
      for (int j2 = 0; j2 < 64; j2++) {
        const u32 w = rowp[j2];
        u32 x0 = (w << 16) | (u32)(127 - 2 * j2);
        u32 x1 = (w & 0xffff0000u) | (u32)(126 - 2 * j2);
        INS16(L, x0)
        INS16(L, x1)
      }
    }
    __syncthreads();
#pragma unroll
    for (int q = 0; q < 4; q++)
      *(uint4*)(listS + tid * 16 + q * 4) = make_uint4(L[4 * q], L[4 * q + 1], L[4 * q + 2], L[4 * q + 3]);
    __syncthreads();
    int eidx[16];
    float gate[16];
    if (tid < 128) {
      const int token = tid >> 3, head = tid & 7;
      const u32* la = listS + (token * 16 + head * 2) * 16;
      const u32* lb = la + 16;
      float av[16], bv[16];
#pragma unroll
      for (int q = 0; q < 4; q++) {
        const uint4 wa = *(const uint4*)(la + 4 * q), wb = *(const uint4*)(lb + 4 * q);
        av[4 * q] = unordk(wa.x & 0xffff0000u); av[4 * q + 1] = unordk(wa.y & 0xffff0000u);
        av[4 * q + 2] = unordk(wa.z & 0xffff0000u); av[4 * q + 3] = unordk(wa.w & 0xffff0000u);
        bv[4 * q] = unordk(wb.x & 0xffff0000u); bv[4 * q + 1] = unordk(wb.y & 0xffff0000u);
        bv[4 * q + 2] = unordk(wb.z & 0xffff0000u); bv[4 * q + 3] = unordk(wb.w & 0xffff0000u);
      }
      u32 T[16];
#pragma unroll
      for (int q = 0; q < 16; q++) T[q] = 0u;
      {
        int slot = 0;
#pragma unroll
        for (int ia = 0; ia < 16; ia++)
#pragma unroll
          for (int ib = 0; ib < 16; ib++)
            if ((ia + 1) * (ib + 1) <= 16) {
              u32 x = (ordk(av[ia] + bv[ib]) & ~63u) | (u32)(63 - slot);
              INS16(T, x)
              slot++;
            }
      }
      float e[16], ssum = 0.f;
      const float vmax = unordk(T[0] & ~63u);
#pragma unroll
      for (int k = 0; k < 16; k++) { e[k] = __expf(unordk(T[k] & ~63u) - vmax); ssum += e[k]; }
      const float rs = __builtin_amdgcn_rcpf(ssum);
#pragma unroll
      for (int k = 0; k < 16; k++) {
        const u32 code = stairS[63 - (int)(T[k] & 63u)];
        const int ia = 127 - (int)(la[(code >> 4) & 15] & 127u), ib = 127 - (int)(lb[code & 15] & 127u);
        eidx[k] = ia * 128 + ib;
        gate[k] = e[k] * rs;
      }
#pragma unroll
      for (int b = 0; b < 8; b++) {
        int c = 0;
#pragma unroll
        for (int k = 0; k < 16; k++) c += ((eidx[k] >> 11) == b) ? 1 : 0;
        cntS[(token * 8 + head) * 8 + b] = c;
      }
    }
    __syncthreads();
    if (tid < 128) {
      const int token = tid >> 3, head = tid & 7;
      int base[8];
      {
        int run = 0;
#pragma unroll
        for (int b = 0; b < 8; b++) {
          int mine = 0, tot = 0;
#pragma unroll
          for (int hh = 0; hh < 8; hh++) {
            const int c = cntS[(token * 8 + hh) * 8 + b];
            mine += (hh < head) ? c : 0;
            tot += c;
          }
          base[b] = run + mine;
          run += tot;
        }
      }
      float2* ro = ROUTE + (size_t)(tok0 + token) * 128;
#pragma unroll
      for (int k = 0; k < 16; k++) {
        const int bk = eidx[k] >> 11;
        int pos = 0;
#pragma unroll
        for (int b = 0; b < 8; b++) pos += (bk == b) ? base[b] : 0;
#pragma unroll
        for (int k2 = 0; k2 < 16; k2++)
          if (k2 < k) pos += ((eidx[k2] >> 11) == bk) ? 1 : 0;
        ro[pos] = make_float2(gate[k], __int_as_float(eidx[k]));
      }
    }
  }
}
#undef INS16

__device__ __forceinline__ void unpack8(uint4 w, float* f) {
  f[0] = lo16(w.x); f[1] = hi16(w.x); f[2] = lo16(w.y); f[3] = hi16(w.y);
  f[4] = lo16(w.z); f[5] = hi16(w.z); f[6] = lo16(w.w); f[7] = hi16(w.w);
}

__device__ __forceinline__ void unpack_fp8x16(uint4 w, float* f) {
  typedef float f2_ __attribute__((ext_vector_type(2)));
  f2_ t;
  t = __builtin_amdgcn_cvt_pk_f32_fp8((int)w.x, false); f[0] = t.x; f[1] = t.y;
  t = __builtin_amdgcn_cvt_pk_f32_fp8((int)w.x, true); f[2] = t.x; f[3] = t.y;
  t = __builtin_amdgcn_cvt_pk_f32_fp8((int)w.y, false); f[4] = t.x; f[5] = t.y;
  t = __builtin_amdgcn_cvt_pk_f32_fp8((int)w.y, true); f[6] = t.x; f[7] = t.y;
  t = __builtin_amdgcn_cvt_pk_f32_fp8((int)w.z, false); f[8] = t.x; f[9] = t.y;
  t = __builtin_amdgcn_cvt_pk_f32_fp8((int)w.z, true); f[10] = t.x; f[11] = t.y;
  t = __builtin_amdgcn_cvt_pk_f32_fp8((int)w.w, false); f[12] = t.x; f[13] = t.y;
  t = __builtin_amdgcn_cvt_pk_f32_fp8((int)w.w, true); f[14] = t.x; f[15] = t.y;
}

__device__ __forceinline__ void phase_peer(const Params& p) {
  char* ws = p.ws;
  const unsigned char* PU = (const unsigned char*)(ws + OFF_PU);
  const unsigned char* PV = (const unsigned char*)(ws + OFF_PV);
  const u16* Hf = (const u16*)(ws + OFF_H);
  const float2* ROUTE = (const float2*)(ws + OFF_ROUTE);
  const int lane = threadIdx.x & 63;
  const int gw = blockIdx.x * 4 + (threadIdx.x >> 6), nw = gridDim.x * 4;
#pragma unroll 1
  for (int tk = gw; tk < NT; tk += nw) {
    float xf[16], o[16];
    unpack8(*(const uint4*)(Hf + (size_t)tk * HLD + lane * 16), xf);
    unpack8(*(const uint4*)(Hf + (size_t)tk * HLD + lane * 16 + 8), xf + 8);
#pragma unroll
    for (int j = 0; j < 16; j++) o[j] = 0.f;
    const float2* rt = ROUTE + (size_t)tk * 128;
    float2 rA[4], rB[4];
    uint4 uA[4], vA[4], uB[4], vB[4];
#define PLOAD(R, U, V, E)                                                        \
  _Pragma("unroll") for (int q = 0; q < 4; q++) {                                \
    R[q] = rt[(E) + q];                                                          \
    const size_t off = (size_t)__float_as_int(R[q].y) * 2048 + lane * 16;        \
    U[q] = *(const uint4*)(PU + off);                                            \
    V[q] = *(const uint4*)(PU + off + 1024);                                     \
  }
#define PCOMP(R, U, V)                                                           \
  _Pragma("unroll") for (int q = 0; q < 4; q++) {                                \
    float uf[16];                                                                \
    unpack_fp8x16(U[q], uf);                                                     \
    float d = 0.f;                                                               \
    _Pragma("unroll") for (int j = 0; j < 16; j++) d += uf[j] * xf[j];           \
    d = wave_sum(d) * (1.f / 64.f);                                              \
    const float act = 0.5f * d * (1.f + erff(d * 0.70710678118654752f));         \
    const float cf = R[q].x * act * (1.f / 16.f);                                \
    float vf[16];                                                                \
    unpack_fp8x16(V[q], vf);                                                     \
    _Pragma("unroll") for (int j = 0; j < 16; j++) o[j] += cf * vf[j];           \
  }
    PLOAD(rA, uA, vA, 0)
#pragma unroll 1
    for (int e = 0; e < 128; e += 8) {
      PLOAD(rB, uB, vB, e + 4)
      PCOMP(rA, uA, vA)
      if (e + 8 < 128) { PLOAD(rA, uA, vA, e + 8) }
      PCOMP(rB, uB, vB)
    }
#undef PLOAD
#undef PCOMP
    float* yr = p.out + (size_t)tk * 1024 + lane * 16;
    float4 x0 = *(const float4*)(yr), x1 = *(const float4*)(yr + 4), x2 = *(const float4*)(yr + 8), x3 = *(const float4*)(yr + 12);
    o[0] += x0.x; o[1] += x0.y; o[2] += x0.z; o[3] += x0.w; o[4] += x1.x; o[5] += x1.y; o[6] += x1.z; o[7] += x1.w;
    o[8] += x2.x; o[9] += x2.y; o[10] += x2.z; o[11] += x2.w; o[12] += x3.x; o[13] += x3.y; o[14] += x3.z; o[15] += x3.w;
    float ss = 0.f;
#pragma unroll
    for (int j = 0; j < 16; j++) ss += o[j] * o[j];
    ss = wave_sum(ss);
    const float rr = rsqrtf(ss * (1.f / 1024.f) + 1e-6f);
    const float* gf = p.g_final + lane * 16;
    float4 g0 = *(const float4*)(gf), g1 = *(const float4*)(gf + 4), g2 = *(const float4*)(gf + 8), g3 = *(const float4*)(gf + 12);
    *(float4*)(yr) = make_float4(o[0] * rr * g0.x, o[1] * rr * g0.y, o[2] * rr * g0.z, o[3] * rr * g0.w);
    *(float4*)(yr + 4) = make_float4(o[4] * rr * g1.x, o[5] * rr * g1.y, o[6] * rr * g1.z, o[7] * rr * g1.w);
    *(float4*)(yr + 8) = make_float4(o[8] * rr * g2.x, o[9] * rr * g2.y, o[10] * rr * g2.z, o[11] * rr * g2.w);
    *(float4*)(yr + 12) = make_float4(o[12] * rr * g3.x, o[13] * rr * g3.y, o[14] * rr * g3.z, o[15] * rr * g3.w);
  }
}

#define XB_TMO      128
#define XB_XCNT(j)  (256  + 64 * (j))
#define XB_XSUB(j)  (1280 + 64 * (j))
#define XB_XGEN(j)  (2304 + 64 * (j))
#define XB_TOP      3328
#define XB_TOPGEN   3392
#define XCD_BAR_WORDS 3456
#define XB_SPIN_CAP (1u << 18)
#define LAS __attribute__((address_space(3)))
__device__ __forceinline__ unsigned xb_ld(unsigned* p) { return __hip_atomic_load(p, __ATOMIC_RELAXED, __HIP_MEMORY_SCOPE_AGENT); }
__device__ __forceinline__ unsigned xb_add(unsigned* p, unsigned v) { return __hip_atomic_fetch_add(p, v, __ATOMIC_RELAXED, __HIP_MEMORY_SCOPE_AGENT); }
__device__ __forceinline__ unsigned xb_xcc_id() { return (unsigned)__builtin_amdgcn_s_getreg((3 << 11) | 20) & 0xFu; }
#define XB_SPIN(cond, bar) do { unsigned _sp = 0; while (cond) { __builtin_amdgcn_s_sleep(1); \
    if ((++_sp & 255u) == 0u) { if (xb_ld(&(bar)[XB_TMO])) break; if (_sp > XB_SPIN_CAP) { atomicAdd(&(bar)[XB_TMO], 1u); break; } } } } while (0)
struct XcdBarrier { unsigned* bar; unsigned x; volatile LAS unsigned* st; };
__device__ __forceinline__ XcdBarrier xcd_barrier_post(unsigned* bar, volatile LAS unsigned* st) {
  XcdBarrier b; b.bar = bar; b.x = xb_xcc_id(); b.st = st;
  if (threadIdx.x == 0) (void)xb_add(&bar[XB_XCNT(b.x)], 1u);
  return b;
}
__device__ __forceinline__ void xcd_barrier_complete(unsigned* bar, unsigned x, unsigned& nloc, unsigned& nx) {
  const unsigned G = gridDim.x * gridDim.y * gridDim.z;
  unsigned sum, cnt, mine, sp = 0u;
  for (;;) {
    sum = 0u; cnt = 0u; mine = 0u;
#pragma unroll
    for (unsigned j = 0; j < 16; ++j) { const unsigned c = xb_ld(&bar[XB_XCNT(j)]); sum += c; cnt += (c > 0u) ? 1u : 0u; mine = (j == x) ? c : mine; }
    if (sum == G) break;
    __builtin_amdgcn_s_sleep(1);
    if ((++sp & 255u) == 0u) { if (xb_ld(&bar[XB_TMO])) break; if (sp > XB_SPIN_CAP) { atomicAdd(&bar[XB_TMO], 1u); break; } }
  }
  nloc = mine > 0u ? mine : 1u; nx = cnt > 0u ? cnt : 1u;
}
__device__ __forceinline__ void xcd_barrier(unsigned* bbar, unsigned bx, volatile LAS unsigned* bst) {
  asm volatile("s_waitcnt vmcnt(0)" ::: "memory");
  __syncthreads();
  if (threadIdx.x == 0) {
    unsigned* bar = bbar;
    __builtin_amdgcn_s_waitcnt(0);
    unsigned nloc = bst[0], nx = bst[1];
    if (nloc == 0u) { xcd_barrier_complete(bar, bx, nloc, nx); bst[0] = nloc; bst[1] = nx; }
    const unsigned old = xb_add(&bar[XB_XSUB(bx)], 1u);
    const unsigned gen = old / nloc;
    if (old + 1u == (gen + 1u) * nloc) {
      __builtin_amdgcn_fence(__ATOMIC_RELEASE, "agent");
      asm volatile("s_waitcnt vmcnt(0)" ::: "memory");
      const unsigned og = xb_add(&bar[XB_TOP], 1u);
      const unsigned tg = og / nx;
      if (og + 1u == (tg + 1u) * nx) xb_add(&bar[XB_TOPGEN], 1u);
      else XB_SPIN(xb_ld(&bar[XB_TOPGEN]) == tg, bar);
      __builtin_amdgcn_fence(__ATOMIC_ACQUIRE, "agent");
      xb_add(&bar[XB_XGEN(bx)], 1u);
      asm volatile("s_waitcnt vmcnt(0)" ::: "memory");
    } else {
      XB_SPIN(xb_ld(&bar[XB_XGEN(bx)]) == gen, bar);
      __builtin_amdgcn_fence(__ATOMIC_ACQUIRE, "agent");
      asm volatile("s_waitcnt vmcnt(0)" ::: "memory");
    }
  }
  __syncthreads();
}

__global__ void __launch_bounds__(256, 2) fwd_kernel(Params pk) {
  __shared__ __attribute__((aligned(16))) char smem[SMEM_BYTES];
  __shared__ int s_item;
  __shared__ uint4 xb_words;
  if (threadIdx.x == 0) xb_words = make_uint4(0u, 0u, 0u, 0u);
  __syncthreads();
  unsigned* const xb_bar = (unsigned*)(pk.ws + OFF_BAR);
  volatile LAS unsigned* const xb_st = (volatile LAS unsigned*)&xb_words;
  const unsigned xb_x = xb_xcc_id();
  if (threadIdx.x == 0) (void)xb_add(&xb_bar[XB_XCNT(xb_x)], 1u);
#ifdef ONLY_PHASE
#define RUN(PH, ...) if (PH == ONLY_PHASE) { const Params& p = pk; char* ws = p.ws; (void)ws; __VA_ARGS__; }
#else
typedef const Params __attribute__((address_space(4))) * KParamsPtr;
#if defined(__HIP_DEVICE_COMPILE__)
#define LOAD_PARAMS                                                                   \
  KParamsPtr kp_ = (KParamsPtr)__builtin_amdgcn_kernarg_segment_ptr();                \
  asm volatile("" : "+s"(kp_));                                                       \
  const Params p = *kp_;
#else
#define LOAD_PARAMS const Params p = pk;
#endif
#define RUN(PH, ...)                                   \
  if (pk.ph0 <= PH && PH < pk.ph1) {                   \
    {                                                  \
      LOAD_PARAMS                                      \
      char* ws = p.ws;                                 \
      (void)ws;                                        \
      __VA_ARGS__;                                     \
    }                                                  \
    if (PH + 1 < pk.ph1) xcd_barrier(xb_bar, xb_x, xb_st); \
  }
#endif
  RUN(0, phase_prep(p, smem))
  RUN(1, phase_gemm_in(p, smem))
  RUN(2, phase_conv(p))
  RUN(3, phase_mixers(p, smem, &s_item))
  RUN(4, mlstm_scan(p))
  RUN(5, phase_mlstm_out(p, smem))
  RUN(6, phase_mixed(p, smem))
  RUN(7, phase_gemm_generic(p, smem, (const u16*)(ws + OFF_H), (const u16*)(ws + OFF_WT_OUT), 8, 0, nullptr, 0))
  RUN(8, phase_norm(p, p.g_cross))
  RUN(9, phase_gemm_generic(p, smem, (const u16*)(ws + OFF_H), (const u16*)(ws + OFF_WT_CQ), 8, 2, (u16*)(ws + OFF_QC), HLD))
  RUN(10, phase_cross(p, smem))
  RUN(11, phase_gemm_generic(p, smem, (const u16*)(ws + OFF_QC), (const u16*)(ws + OFF_WT_CO), 8, 1, nullptr, 0))
  RUN(12, phase_norm(p, p.g_ffn))
  RUN(13, phase_gemm_generic(p, smem, (const u16*)(ws + OFF_H), (const u16*)(ws + OFF_WT_PQ), 16, 2, (u16*)(ws + OFF_PQ), PQLD))
  RUN(14, phase_route(p, smem))
  RUN(15, phase_peer(p))
  if (pk.ph0 < 0) cg::this_grid().sync();
}

extern "C" void kernel_launch(void* const* d_in, const int* in_sizes, int n_in, void* d_out, int out_size, void* d_ws,
                              size_t ws_size, hipStream_t stream) {
  static int grid_blocks = 0;
  static int cus = 0;
  if (!cus) {
    int dev = 0;
    (void)hipGetDevice(&dev);
    (void)hipDeviceGetAttribute(&cus, hipDeviceAttributeMultiprocessorCount, dev);
    if (cus <= 0) cus = 256;
  }
  Params p;
  memset(&p, 0, sizeof(p));
  const float** f = (const float**)&p;
  for (int i = 0; i < 33; i++) f[i] = (const float*)d_in[i];
  p.out = (float*)d_out;
  p.ws = (char*)d_ws;
#if COOP
  p.ph0 = 0; p.ph1 = NPHASE;
  void* args[] = {&p};
  (void)hipMemsetAsync((char*)d_ws + OFF_BAR, 0, XCD_BAR_WORDS * 4, stream);
  if (!grid_blocks) {
    hipError_t e = hipLaunchCooperativeKernel((void*)fwd_kernel, dim3(2 * cus), dim3(256), args, 0, stream);
    if (e == hipSuccess) { grid_blocks = 2 * cus; return; }
    (void)hipGetLastError();
    grid_blocks = cus;
  }
  hipError_t e = hipLaunchCooperativeKernel((void*)fwd_kernel, dim3(grid_blocks), dim3(256), args, 0, stream);
  if (e != hipSuccess) fprintf(stderr, "cooperative launch failed: %s (grid %d)\n", hipGetErrorString(e), grid_blocks);
#else
  for (int ph = 0; ph < NPHASE; ph++) {
    p.ph0 = ph; p.ph1 = ph + 1;
    hipLaunchKernelGGL(fwd_kernel, dim3(2 * cus), dim3(256), 0, stream, p);
  }
#endif
}
```

```cpp
#include <hip/hip_runtime.h>
#include <hip/hip_cooperative_groups.h>
#include <cstdio>
#include <cstring>
namespace cg = cooperative_groups;

#ifndef COOP
#define COOP 1
#endif

typedef unsigned short u16;
typedef unsigned int u32;
typedef __attribute__((ext_vector_type(8))) short bf16x8;
typedef __attribute__((ext_vector_type(4))) float f32x4;
#define MFMA(a, b, c) __builtin_amdgcn_mfma_f32_16x16x32_bf16(a, b, c, 0, 0, 0)

constexpr int NT = 16896;
constexpr int NP = 16384;
constexpr int ZLD = 3712;
constexpr int NPHASE = 16;
constexpr int HLD = 1152;
constexpr int WLD5 = 640;
constexpr int PQLD = 2176;
constexpr int VLD = 17024;

constexpr size_t OFF_WT_IN = 0;
constexpr size_t OFF_WT_AUP = OFF_WT_IN + 5760ull * HLD * 2;
constexpr size_t OFF_WT_BUP = OFF_WT_AUP + 1024ull * WLD5 * 2;
constexpr size_t OFF_WT_OUT = OFF_WT_BUP + 1024ull * WLD5 * 2;
constexpr size_t OFF_WT_MKV = OFF_WT_OUT + 1024ull * HLD * 2;
constexpr size_t OFF_WT_CQ = OFF_WT_MKV + 2048ull * HLD * 2;
constexpr size_t OFF_WT_CO = OFF_WT_CQ + 1024ull * HLD * 2;
constexpr size_t OFF_WT_PQ = OFF_WT_CO + 1024ull * HLD * 2;
constexpr size_t OFF_SUBK = OFF_WT_PQ + 2048ull * HLD * 2;
constexpr size_t OFF_CTR = OFF_SUBK + 262144ull * 2;
constexpr size_t OFF_P = OFF_CTR + 4096;
constexpr size_t OFF_PU = OFF_P;
constexpr size_t OFF_PV = OFF_P + 16384ull * 1024;
constexpr size_t OFF_ROUTE = OFF_P + 2ull * 16384 * 1024;
constexpr size_t OFF_KC = OFF_P;
constexpr size_t OFF_VCT = OFF_KC + 16ull * 512 * 512 * 2;
constexpr size_t OFF_VAT = OFF_VCT + 16ull * 512 * 512 * 2;
constexpr size_t OFF_VBT = OFF_VAT + 512ull * VLD * 2;
constexpr size_t OFF_MN = OFF_VBT + 512ull * VLD * 2;
constexpr size_t OFF_H = OFF_P + 2ull * 16384 * 1024 * 2;
constexpr size_t OFF_Z = OFF_H + (size_t)NT * HLD * 2;
constexpr size_t OFF_QC = OFF_Z;
constexpr size_t OFF_PQ = OFF_Z + (size_t)NT * HLD * 2;
constexpr size_t OFF_MK = OFF_Z + (size_t)NT * ZLD * 2;
constexpr size_t OFF_MVT = OFF_MK + 6144ull * HLD * 2;
constexpr size_t OFF_DELTA = OFF_MVT + 6144ull * 1024 * 2;
constexpr size_t OFF_NBUF = OFF_DELTA + 1024ull * 16384 * 2;
constexpr size_t OFF_SCAL = OFF_NBUF + 1024ull * 128 * 4;
constexpr size_t OFF_BAR = OFF_SCAL + 1024ull * 4 * 4;
constexpr size_t WS_END = OFF_BAR + 16384;
static_assert(OFF_MN + 2048ull * HLD * 2 <= OFF_H, "early scratch overflows peer region");
static_assert(OFF_ROUTE + (size_t)NT * 128 * 8 <= OFF_H, "route overflows peer region");
static_assert(OFF_PQ + (size_t)NT * PQLD * 2 <= OFF_MK, "pq overflows z region");
static_assert(WS_END <= 336ull * 1000 * 1000, "workspace budget");

constexpr size_t O_Y = 0;
constexpr size_t O_PAK = (size_t)NT * 1024;
constexpr size_t O_PAV = O_PAK + 2097152;
constexpr size_t O_PBCONV = O_PAV + 2097152;
constexpr size_t O_PBC = O_PBCONV + 24576;
constexpr size_t O_PBN = O_PBC + 524288;
constexpr size_t O_PBM = O_PBN + 4096;
constexpr size_t O_PMK = O_PBM + 32;
constexpr size_t O_PMV = O_PMK + 2097152;
constexpr size_t O_SAK = O_PMV + 2097152;
constexpr size_t O_SAV = O_SAK + 262144;
constexpr size_t O_SBCONV = O_SAV + 262144;
constexpr size_t O_SBC = O_SBCONV + 49152;
constexpr size_t O_SBN = O_SBC + 1048576;
constexpr size_t O_SBM = O_SBN + 8192;

constexpr int SMEM_BYTES = 79872;

struct Params {
  const float *x_prompt, *x_sample, *mem_prompt, *cache_a_k, *cache_a_v, *state_b_conv, *state_b_C, *state_b_n,
      *state_b_m, *cache_mem_k, *cache_mem_v;
  const float *g_mix, *w_in, *conv_w, *conv_b, *b_if, *g_head, *rel_bias, *w_a_up, *w_b_up, *w_out, *g_mem, *w_mk,
      *w_mv, *g_cross, *w_cq, *w_co, *g_ffn, *w_pq, *sub_keys, *peer_u, *peer_v, *g_final;
  float* out;
  char* ws;
  int ph0, ph1;
};

__device__ __forceinline__ float bf2f(u16 h) { return __uint_as_float(((u32)h) << 16); }
__device__ __forceinline__ u32 pack2(float lo, float hi) {
  u32 r;
  asm("v_cvt_pk_bf16_f32 %0,%1,%2" : "=v"(r) : "v"(lo), "v"(hi));
  return r;
}
__device__ __forceinline__ u16 f2bf(float f) { return (u16)(pack2(f, 0.f) & 0xffffu); }
__device__ __forceinline__ float lo16(u32 w) { return __uint_as_float(w << 16); }
__device__ __forceinline__ float hi16(u32 w) { return __uint_as_float(w & 0xffff0000u); }

template <int CTRL>
__device__ __forceinline__ float dppf(float v) {
  return __int_as_float(__builtin_amdgcn_update_dpp(0, __float_as_int(v), CTRL, 0xF, 0xF, true));
}
template <int CTRL>
__device__ __forceinline__ u32 dppu(u32 v) {
  return (u32)__builtin_amdgcn_update_dpp(0, (int)v, CTRL, 0xF, 0xF, true);
}
__device__ __forceinline__ float row16_sum(float v) {
  v += dppf<0xB1>(v); v += dppf<0x4E>(v); v += dppf<0x141>(v); v += dppf<0x140>(v);
  return v;
}
__device__ __forceinline__ float row16_max(float v) {
  v = fmaxf(v, dppf<0xB1>(v)); v = fmaxf(v, dppf<0x4E>(v)); v = fmaxf(v, dppf<0x141>(v)); v = fmaxf(v, dppf<0x140>(v));
  return v;
}
__device__ __forceinline__ u32 umax2(u32 a, u32 b) { return a > b ? a : b; }
__device__ __forceinline__ u32 row16_umax(u32 v) {
  v = umax2(v, dppu<0xB1>(v)); v = umax2(v, dppu<0x4E>(v)); v = umax2(v, dppu<0x141>(v)); v = umax2(v, dppu<0x140>(v));
  return v;
}
__device__ __forceinline__ float wave_sum(float v) {
  v = row16_sum(v);
  v += __shfl_xor(v, 16);
  v += __shfl_xor(v, 32);
  return v;
}
__device__ __forceinline__ u32 ordk(float f) {
  u32 u = __float_as_uint(f);
  return u ^ ((u32)((int)u >> 31) | 0x80000000u);
}
__device__ __forceinline__ float unordk(u32 k) { return __uint_as_float(k ^ ((~(u32)((int)k >> 31)) | 0x80000000u)); }
__device__ __forceinline__ float sigmoidf_(float x) { return __builtin_amdgcn_rcpf(1.f + __expf(-x)); }
__device__ __forceinline__ uint4 zero4() { return make_uint4(0, 0, 0, 0); }

__device__ __forceinline__ void transpose_tile(const float* __restrict__ src, int src_ld, int k0, int c0, int col_lim,
                               u16* __restrict__ dst, int dst_ld, int dst_r0, float* tile) {
  const int tid = threadIdx.x, c = tid & 63, r4 = tid >> 6;
  {
    float tv[16];
    const int cc0 = c < col_lim ? c : 0;
#pragma unroll
    for (int i = 0; i < 16; i++) tv[i] = src[(size_t)(k0 + r4 + 4 * i) * src_ld + c0 + cc0];
#pragma unroll
    for (int i = 0; i < 16; i++) tile[(r4 + 4 * i) * 65 + c] = (c < col_lim) ? tv[i] : 0.f;
  }
  __syncthreads();
#pragma unroll 4
  for (int i = 0; i < 16; i++) {
    int cc = r4 + 4 * i;
    dst[(size_t)(dst_r0 + cc) * dst_ld + k0 + c] = f2bf(tile[c * 65 + cc]);
  }
  __syncthreads();
}

__device__ __forceinline__ void rms_row_to_bf16(const float* __restrict__ src, const float* __restrict__ g,
                                                u16* __restrict__ dst, int lane) {
  float4 v[4];
  float ss = 0.f;
#pragma unroll
  for (int i = 0; i < 4; i++) {
    v[i] = ((const float4*)src)[lane + 64 * i];
    ss += v[i].x * v[i].x + v[i].y * v[i].y + v[i].z * v[i].z + v[i].w * v[i].w;
  }
  ss = wave_sum(ss);
  float r = rsqrtf(ss * (1.f / 1024.f) + 1e-6f);
#pragma unroll
  for (int i = 0; i < 4; i++) {
    float4 gg = ((const float4*)g)[lane + 64 * i];
    uint2 o;
    o.x = pack2(v[i].x * r * gg.x, v[i].y * r * gg.y);
    o.y = pack2(v[i].z * r * gg.z, v[i].w * r * gg.w);
    ((uint2*)dst)[lane + 64 * i] = o;
  }
}

__device__ __forceinline__ void cvt_bf16(const float* __restrict__ src, u16* __restrict__ dst, size_t n) {
  size_t n8 = n >> 3;
  for (size_t i = (size_t)blockIdx.x * 256 + threadIdx.x; i < n8; i += (size_t)gridDim.x * 256) {
    float4 a = ((const float4*)src)[2 * i], b = ((const float4*)src)[2 * i + 1];
    uint4 o;
    o.x = pack2(a.x, a.y); o.y = pack2(a.z, a.w); o.z = pack2(b.x, b.y); o.w = pack2(b.z, b.w);
    ((uint4*)dst)[i] = o;
  }
}

__device__ __forceinline__ void cvt_fp8(const float* __restrict__ src, unsigned char* __restrict__ dst, size_t n, float scale) {
  size_t n16 = n >> 4;
  for (size_t i = (size_t)blockIdx.x * 256 + threadIdx.x; i < n16; i += (size_t)gridDim.x * 256) {
    const float4* sp = (const float4*)src + 4 * i;
    float4 a = sp[0], b = sp[1], c = sp[2], d = sp[3];
    int w0 = 0, w1 = 0, w2 = 0, w3 = 0;
    w0 = __builtin_amdgcn_cvt_pk_fp8_f32(a.x * scale, a.y * scale, w0, false);
    w0 = __builtin_amdgcn_cvt_pk_fp8_f32(a.z * scale, a.w * scale, w0, true);
    w1 = __builtin_amdgcn_cvt_pk_fp8_f32(b.x * scale, b.y * scale, w1, false);
    w1 = __builtin_amdgcn_cvt_pk_fp8_f32(b.z * scale, b.w * scale, w1, true);
    w2 = __builtin_amdgcn_cvt_pk_fp8_f32(c.x * scale, c.y * scale, w2, false);
    w2 = __builtin_amdgcn_cvt_pk_fp8_f32(c.z * scale, c.w * scale, w2, true);
    w3 = __builtin_amdgcn_cvt_pk_fp8_f32(d.x * scale, d.y * scale, w3, false);
    w3 = __builtin_amdgcn_cvt_pk_fp8_f32(d.z * scale, d.w * scale, w3, true);
    *(uint4*)(dst + (i >> 6) * 2048 + (i & 63) * 16) = make_uint4((u32)w0, (u32)w1, (u32)w2, (u32)w3);
  }
}

__device__ __forceinline__ void prep_jobs(const Params& p, char* smem, int jlo, int jhi) {
  float* tile = (float*)smem;
  char* ws = p.ws;
  for (int j = jlo + blockIdx.x; j < jhi; j += gridDim.x) {
    if (j < 928) { int kt = j & 15, nt = j >> 4;
      transpose_tile(p.w_in, 5640, kt * 64, nt * 64, 3592 - nt * 64, (u16*)(ws + OFF_WT_IN), HLD, nt * 64, tile);
    } else if (j < 1440) { int q = j - 928; int kt = q & 15, nt = q >> 4;
      transpose_tile(p.w_in, 5640, kt * 64, 3592 + nt * 64, 64, (u16*)(ws + OFF_WT_IN), HLD, 3712 + nt * 64, tile);
    } else if (j < 1568) { int q = j - 1440; int kt = q & 7, nt = q >> 3;
      transpose_tile(p.w_a_up, 1024, kt * 64, nt * 64, 64, (u16*)(ws + OFF_WT_AUP), WLD5, nt * 64, tile);
    } else if (j < 1696) { int q = j - 1568; int kt = q & 7, nt = q >> 3;
      transpose_tile(p.w_b_up, 1024, kt * 64, nt * 64, 64, (u16*)(ws + OFF_WT_BUP), WLD5, nt * 64, tile);
    } else if (j < 1952) { int q = j - 1696; int kt = q & 15, nt = q >> 4;
      transpose_tile(p.w_out, 1024, kt * 64, nt * 64, 64, (u16*)(ws + OFF_WT_OUT), HLD, nt * 64, tile);
    } else if (j < 2208) { int q = j - 1952; int kt = q & 15, nt = q >> 4;
      transpose_tile(p.w_mk, 1024, kt * 64, nt * 64, 64, (u16*)(ws + OFF_WT_MKV), HLD, nt * 64, tile);
    } else if (j < 2464) { int q = j - 2208; int kt = q & 15, nt = q >> 4;
      transpose_tile(p.w_mv, 1024, kt * 64, nt * 64, 64, (u16*)(ws + OFF_WT_MKV), HLD, 1024 + nt * 64, tile);
    } else if (j < 2720) { int q = j - 2464; int kt = q & 15, nt = q >> 4;
      transpose_tile(p.w_cq, 1024, kt * 64, nt * 64, 64, (u16*)(ws + OFF_WT_CQ), HLD, nt * 64, tile);
    } else if (j < 2976) { int q = j - 2720; int kt = q & 15, nt = q >> 4;
      transpose_tile(p.w_co, 1024, kt * 64, nt * 64, 64, (u16*)(ws + OFF_WT_CO), HLD, nt * 64, tile);
    } else if (j < 3488) { int q = j - 2976; int kt = q & 15, nt = q >> 4;
      transpose_tile(p.w_pq, 2048, kt * 64, nt * 64, 64, (u16*)(ws + OFF_WT_PQ), HLD, nt * 64, tile);
    } else if (j < 4512) { int q = j - 3488; int kt = q & 7, nt = (q >> 3) & 7, sb = q >> 6;
      transpose_tile(p.cache_a_v + (size_t)sb * 512 * 512, 512, kt * 64, nt * 64, 64,
                     (u16*)(ws + OFF_VCT) + (size_t)sb * 512 * 512, 512, nt * 64, tile);
    } else { int q = j - 4512; int kt = q & 3, nt = (q >> 2) & 15, sb = q >> 6;
      transpose_tile(p.cache_mem_v + (size_t)sb * 256 * 1024, 1024, kt * 64, nt * 64, 64,
                     (u16*)(ws + OFF_MVT) + (size_t)(8 + sb) * 1024 * 256, 256, nt * 64, tile);
    }
  }
}

__device__ __forceinline__ void prep_memk(const Params& p) {
  char* ws = p.ws;
  {
    u16* MKs = (u16*)(ws + OFF_MK) + 2048ull * HLD;
    for (size_t i = (size_t)blockIdx.x * 256 + threadIdx.x; i < 4096ull * 128; i += (size_t)gridDim.x * 256) {
      const size_t r = i >> 7, c8 = (i & 127) * 8;
      const float4 a = *(const float4*)(p.cache_mem_k + r * 1024 + c8), b = *(const float4*)(p.cache_mem_k + r * 1024 + c8 + 4);
      uint4 o;
      o.x = pack2(a.x, a.y); o.y = pack2(a.z, a.w); o.z = pack2(b.x, b.y); o.w = pack2(b.z, b.w);
      *(uint4*)(MKs + r * HLD + c8) = o;
    }
  }
}

__device__ __forceinline__ void phase_prep(const Params& p, char* smem) {
  char* ws = p.ws;
  if (blockIdx.x == 0 && threadIdx.x < 16) ((int*)(ws + OFF_CTR))[threadIdx.x] = 0;
  prep_jobs(p, smem, 0, 1440);
  prep_jobs(p, smem, 1952, 2464);
  prep_jobs(p, smem, 3488, 4512);
  const int lane = threadIdx.x & 63, gw = blockIdx.x * 4 + (threadIdx.x >> 6), nw = gridDim.x * 4;
  for (int r = gw; r < NT + 2048; r += nw) {
    if (r < NP) rms_row_to_bf16(p.x_prompt + (size_t)r * 1024, p.g_mix, (u16*)(ws + OFF_H) + (size_t)r * HLD, lane);
    else if (r < NT) rms_row_to_bf16(p.x_sample + (size_t)(r - NP) * 1024, p.g_mix, (u16*)(ws + OFF_H) + (size_t)r * HLD, lane);
    else rms_row_to_bf16(p.mem_prompt + (size_t)(r - NT) * 1024, p.g_mem, (u16*)(ws + OFF_MN) + (size_t)(r - NT) * HLD, lane);
  }
  cvt_bf16(p.cache_a_k, (u16*)(ws + OFF_KC), 16ull * 512 * 512);
  cvt_bf16(p.sub_keys, (u16*)(ws + OFF_SUBK), 262144);
}

__device__ __forceinline__ void lds_barrier() {
  asm volatile("s_waitcnt lgkmcnt(0)" ::: "memory");
  __builtin_amdgcn_s_barrier();
  asm volatile("" ::: "memory");
}

__device__ __forceinline__ void gemm_tile(const u16* __restrict__ A, int lda, const u16* __restrict__ Bt, int ldb, int K,
                                          int m0, int n0, u16* smem, f32x4 (&acc)[4][4]) {
  int tid = threadIdx.x;
  asm volatile("" : "+v"(tid));
  const int lane = tid & 63, wave = tid >> 6;
  const int wr = wave >> 1, wc = wave & 1, col = lane & 15, grp = lane >> 4;
  const int c4 = lane & 3, r1 = (lane >> 2) & 1, half = (lane >> 3) & 1, r2 = lane >> 4;
  const int lrow = wave * 8 + r2 * 2 + r1;
  char* As = (char*)smem;
  char* Bs = As + 2 * 16384;
  int wofs;
  {
    const int ob = (lrow & 15) * 64 + c4 * 16;
    wofs = ((lrow >> 4) * 2 + half) * 1024 + (ob ^ (((ob >> 9) & 1) << 5));
  }
  int rofs;
  {
    const int ob = col * 64 + grp * 16;
    rofs = ob ^ (((ob >> 9) & 1) << 5);
  }
  const int aofs = rofs + wr * 8192, bofs = rofs + wc * 8192;
  const u16* Ag = A + (size_t)(m0 + lrow) * lda + half * 32 + c4 * 8;
  const u16* Bg = Bt + (size_t)(n0 + lrow) * ldb + half * 32 + c4 * 8;
  uint4 r0a0, r0a1, r0a2, r0a3, r0b0, r0b1, r0b2, r0b3;
  uint4 r1a0, r1a1, r1a2, r1a3, r1b0, r1b1, r1b2, r1b3;
#define G_LOAD(S, KO)                                                                               \
  S##a0 = *(const uint4*)(Ag + (KO)); S##a1 = *(const uint4*)(Ag + (size_t)32 * lda + (KO));         \
  S##a2 = *(const uint4*)(Ag + (size_t)64 * lda + (KO)); S##a3 = *(const uint4*)(Ag + (size_t)96 * lda + (KO)); \
  S##b0 = *(const uint4*)(Bg + (KO)); S##b1 = *(const uint4*)(Bg + (size_t)32 * ldb + (KO));         \
  S##b2 = *(const uint4*)(Bg + (size_t)64 * ldb + (KO)); S##b3 = *(const uint4*)(Bg + (size_t)96 * ldb + (KO));
#define G_STORE(S, AP, BP)                                                                           \
  *(uint4*)((AP) + wofs) = S##a0; *(uint4*)((AP) + wofs + 4096) = S##a1;                             \
  *(uint4*)((AP) + wofs + 8192) = S##a2; *(uint4*)((AP) + wofs + 12288) = S##a3;                     \
  *(uint4*)((BP) + wofs) = S##b0; *(uint4*)((BP) + wofs + 4096) = S##b1;                             \
  *(uint4*)((BP) + wofs + 8192) = S##b2; *(uint4*)((BP) + wofs + 12288) = S##b3;
#define G_COMPUTE(CUR)                                                                               \
  {                                                                                                  \
    const char* Ac = As + (CUR) * 16384 + aofs;                                                      \
    const char* Bc = Bs + (CUR) * 16384 + bofs;                                                      \
    _Pragma("unroll") for (int ks = 0; ks < 2; ks++) {                                               \
      bf16x8 af0, af1, af2, af3, bq0, bq1, bq2, bq3;                                                 \
      af0 = *(const bf16x8*)(Ac + 0 * 2048 + ks * 1024);                                             \
      af1 = *(const bf16x8*)(Ac + 1 * 2048 + ks * 1024);                                             \
      af2 = *(const bf16x8*)(Ac + 2 * 2048 + ks * 1024);                                             \
      af3 = *(const bf16x8*)(Ac + 3 * 2048 + ks * 1024);                                             \
      bq0 = *(const bf16x8*)(Bc + 0 * 2048 + ks * 1024);                                             \
      bq1 = *(const bf16x8*)(Bc + 1 * 2048 + ks * 1024);                                             \
      bq2 = *(const bf16x8*)(Bc + 2 * 2048 + ks * 1024);                                             \
      bq3 = *(const bf16x8*)(Bc + 3 * 2048 + ks * 1024);                                             \
      acc[0][0] = MFMA(af0, bq0, acc[0][0]); acc[0][1] = MFMA(af0, bq1, acc[0][1]);                  \
      acc[0][2] = MFMA(af0, bq2, acc[0][2]); acc[0][3] = MFMA(af0, bq3, acc[0][3]);                  \
      acc[1][0] = MFMA(af1, bq0, acc[1][0]); acc[1][1] = MFMA(af1, bq1, acc[1][1]);                  \
      acc[1][2] = MFMA(af1, bq2, acc[1][2]); acc[1][3] = MFMA(af1, bq3, acc[1][3]);                  \
      acc[2][0] = MFMA(af2, bq0, acc[2][0]); acc[2][1] = MFMA(af2, bq1, acc[2][1]);                  \
      acc[2][2] = MFMA(af2, bq2, acc[2][2]); acc[2][3] = MFMA(af2, bq3, acc[2][3]);                  \
      acc[3][0] = MFMA(af3, bq0, acc[3][0]); acc[3][1] = MFMA(af3, bq1, acc[3][1]);                  \
      acc[3][2] = MFMA(af3, bq2, acc[3][2]); acc[3][3] = MFMA(af3, bq3, acc[3][3]);                  \
    }                                                                                                \
  }
#define G_STEP(KT, SS)                                                       \
  {                                                                          \
    __builtin_amdgcn_s_setprio(1);                                           \
    G_COMPUTE((KT) & 1)                                                      \
    __builtin_amdgcn_s_setprio(0);                                           \
    G_STORE(SS, As + (((KT) + 1) & 1) * 16384, Bs + (((KT) + 1) & 1) * 16384) \
    { const int kn = min((KT) + 3, nk - 1) * 64; G_LOAD(SS, kn) }            \
    lds_barrier();                                                           \
  }
  const int nk = K >> 6;
  G_LOAD(r0, 0)
  G_LOAD(r1, 64)
  G_STORE(r0, As, Bs)
  G_LOAD(r0, 128)
  lds_barrier();
#pragma unroll 1
  for (int kt = 0; kt < nk; kt += 2) {
    G_STEP(kt, r1)
    G_STEP(kt + 1, r0)
  }
  lds_barrier();
#undef G_LOAD
#undef G_STORE
#undef G_COMPUTE
#undef G_STEP
}

__device__ __forceinline__ bool sched_tile(int NTM, int NTN, int xcd, int j, int& mt, int& nt) {
  const int mb = (NTM * xcd) >> 3, me = (NTM * (xcd + 1)) >> 3, nm = me - mb;
  if (j >= nm * NTN) return false;
  const int nfull = nm >> 3, fullcnt = nfull * 8 * NTN;
  if (j < fullcnt) {
    const int mg = j / (8 * NTN), r = j - mg * 8 * NTN;
    nt = r >> 3; mt = mb + mg * 8 + (r & 7);
  } else {
    const int r = j - fullcnt, gsz = nm - nfull * 8;
    nt = r / gsz; mt = mb + nfull * 8 + (r - nt * gsz);
  }
  return true;
}

constexpr int TLD = 136;
template <bool TR>
__device__ __forceinline__ void epi_stage(f32x4 (&acc)[4][4], u16* T) {
  int lane = threadIdx.x & 63;
  asm volatile("" : "+v"(lane));
  const int wave = threadIdx.x >> 6, wr = wave >> 1, wc = wave & 1, col = lane & 15, grp = lane >> 4;
#pragma unroll
  for (int m = 0; m < 4; m++)
#pragma unroll
    for (int n = 0; n < 4; n++) {
      const int r = wr * 64 + m * 16 + grp * 4, c = wc * 64 + n * 16 + col;
      if (TR) {
        uint2 o; o.x = pack2(acc[m][n][0], acc[m][n][1]); o.y = pack2(acc[m][n][2], acc[m][n][3]);
        *(uint2*)(T + c * TLD + r) = o;
      } else {
#pragma unroll
        for (int j = 0; j < 4; j++) T[(r + j) * TLD + c] = f2bf(acc[m][n][j]);
      }
    }
  lds_barrier();
}
#define EPI_CHUNKS(T, ...)                                              \
  {                                                                     \
    int _t = threadIdx.x;                                               \
    asm volatile("" : "+v"(_t));                                        \
    _Pragma("unroll") for (int _i = 0; _i < 8; _i++) {                  \
      const int _ch = _t + 256 * _i;                                    \
      const int r = _ch >> 4, c8 = (_ch & 15) * 8;                      \
      const uint4 v = *(const uint4*)((T) + r * TLD + c8);              \
      __VA_ARGS__                                                       \
    }                                                                   \
    lds_barrier();                                                      \
  }

#define ACC_ZERO(acc)                                   \
  _Pragma("unroll") for (int m = 0; m < 4; m++)          \
  _Pragma("unroll") for (int n = 0; n < 4; n++) acc[m][n] = f32x4{0.f, 0.f, 0.f, 0.f};

#define EPI_LOOP(acc, m0, n0, ...)                                                               \
  {                                                                                              \
    int _lane = threadIdx.x & 63; const int _wave = threadIdx.x >> 6;                            \
    asm volatile("" : "+v"(_lane));                                                            \
    const int _wr = _wave >> 1, _wc = _wave & 1;                                                 \
    _Pragma("unroll") for (int m = 0; m < 4; m++) _Pragma("unroll") for (int n = 0; n < 4; n++) { \
      const int row = (m0) + _wr * 64 + m * 16 + (_lane >> 4) * 4;                               \
      const int colg = (n0) + _wc * 64 + n * 16 + (_lane & 15);                                  \
      f32x4 v = acc[m][n];                                                                       \
      __VA_ARGS__                                                                                \
    }                                                                                            \
  }

__device__ __forceinline__ void phase_gemm_in(const Params& p, char* smem) {
  char* ws = p.ws;
  const u16* H = (const u16*)(ws + OFF_H);
  u16* Z = (u16*)(ws + OFF_Z);
  u16* VAT = (u16*)(ws + OFF_VAT);
  u16* VBT = (u16*)(ws + OFF_VBT);
  u16* G = (u16*)(p.out);
  const int xcd = blockIdx.x & 7, slot = blockIdx.x >> 3, nslots = gridDim.x >> 3;
  for (int pass = 0; pass < 2; pass++)
  for (int j = slot;; j += nslots) {
    int mt, nt;
    if (!sched_tile(pass == 0 ? 132 : 16, pass == 0 ? 45 : 16, xcd, j, mt, nt)) break;
    f32x4 acc[4][4];
    ACC_ZERO(acc);
    if (pass == 0) {
      const int m0 = mt * 128, n0 = nt * 128;
      gemm_tile(H, HLD, (const u16*)(ws + OFF_WT_IN), HLD, 1024, m0, n0, (u16*)smem, acc);
      u16* T = (u16*)smem;
      if (nt >= 29) {
        epi_stage<false>(acc, T);
        const int ng = n0 - 3712;
        EPI_CHUNKS(T, {
          const int row = m0 + r;
          *(uint4*)(G + (size_t)row * 2048 + ((ng + (row & 15) * 128) & 2047) + c8) = v;
        })
      } else if (nt >= 8 && nt < 12) {
        epi_stage<true>(acc, T);
        EPI_CHUNKS(T, { *(uint4*)(VAT + (size_t)(n0 - 1024 + r) * VLD + m0 + c8) = v; })
      } else if (nt >= 20 && nt < 24) {
        epi_stage<true>(acc, T);
        EPI_CHUNKS(T, { *(uint4*)(VBT + (size_t)(n0 - 2560 + r) * VLD + m0 + c8) = v; })
      } else {
        epi_stage<false>(acc, T);
        EPI_CHUNKS(T, { *(uint4*)(Z + (size_t)(m0 + r) * ZLD + n0 + c8) = v; })
      }
    } else {
      const int m0 = mt * 128, n0 = nt * 128;
      gemm_tile((const u16*)(ws + OFF_MN), HLD, (const u16*)(ws + OFF_WT_MKV), HLD, 1024, m0, n0, (u16*)smem, acc);
      if (nt < 8) {
        u16* MK = (u16*)(ws + OFF_MK);
        float* o = p.out + O_PMK;
        EPI_LOOP(acc, m0, n0, {
          _Pragma("unroll") for (int j = 0; j < 4; j++) {
            o[(size_t)(row + j) * 1024 + colg] = v[j];
            MK[(size_t)(row + j) * HLD + colg] = f2bf(v[j]);
          }
        })
      } else {
        u16* MVT = (u16*)(ws + OFF_MVT);
        float* o = p.out + O_PMV;
        EPI_LOOP(acc, m0, n0 - 1024, {
          _Pragma("unroll") for (int j = 0; j < 4; j++) o[(size_t)(row + j) * 1024 + colg] = v[j];
          uint2 w; w.x = pack2(v[0], v[1]); w.y = pack2(v[2], v[3]);
          const int b = row >> 8, mm = row & 255;
          *(uint2*)(MVT + ((size_t)b * 1024 + colg) * 256 + mm) = w;
        })
      }
    }
  }
}

__device__ __forceinline__ void phase_conv(const Params& p) {
  const u16* Z = (const u16*)(p.ws + OFF_Z);
  u16* QK = (u16*)(p.ws + OFF_H);
  for (int idx = blockIdx.x * 256 + threadIdx.x; idx < NT * 128; idx += gridDim.x * 256) {
    const int row = idx >> 7, c0 = (idx & 127) * 8;
    const bool samp = row >= NP;
    const int t = samp ? ((row - NP) & 31) : (row & 2047);
    const int sb = (row - NP) >> 5;
    float acc[8];
    {
      float4 b0 = *(const float4*)(p.conv_b + c0), b1 = *(const float4*)(p.conv_b + c0 + 4);
      acc[0] = b0.x; acc[1] = b0.y; acc[2] = b0.z; acc[3] = b0.w; acc[4] = b1.x; acc[5] = b1.y; acc[6] = b1.z; acc[7] = b1.w;
    }
    uint4 zw[4];
#pragma unroll
    for (int d = 0; d < 4; d++) zw[d] = *(const uint4*)(Z + (size_t)(row - min(d, t)) * ZLD + 1536 + c0);
#pragma unroll
    for (int d = 0; d < 4; d++) {
      float u[8];
      const uint4 w = zw[d];
      u[0] = lo16(w.x); u[1] = hi16(w.x); u[2] = lo16(w.y); u[3] = hi16(w.y);
      u[4] = lo16(w.z); u[5] = hi16(w.z); u[6] = lo16(w.w); u[7] = hi16(w.w);
      if (t - d < 0) {
        if (samp) {
          const float* pr = p.state_b_conv + (size_t)(sb * 3 + (3 + t - d)) * 1024 + c0;
          float4 a = *(const float4*)pr, b = *(const float4*)(pr + 4);
          u[0] = a.x; u[1] = a.y; u[2] = a.z; u[3] = a.w; u[4] = b.x; u[5] = b.y; u[6] = b.z; u[7] = b.w;
        } else {
#pragma unroll
          for (int e = 0; e < 8; e++) u[e] = 0.f;
        }
      }
      const float* wp = p.conv_w + (3 - d) * 1024 + c0;
      float4 w0 = *(const float4*)wp, w1 = *(const float4*)(wp + 4);
      acc[0] += u[0] * w0.x; acc[1] += u[1] * w0.y; acc[2] += u[2] * w0.z; acc[3] += u[3] * w0.w;
      acc[4] += u[4] * w1.x; acc[5] += u[5] * w1.y; acc[6] += u[6] * w1.z; acc[7] += u[7] * w1.w;
    }
    const float sc = (c0 >= 512) ? 0.08838834764831845f : 1.f;
#pragma unroll
    for (int e = 0; e < 8; e++) acc[e] = acc[e] * sigmoidf_(acc[e]) * sc;
    uint4 o;
    o.x = pack2(acc[0], acc[1]); o.y = pack2(acc[2], acc[3]); o.z = pack2(acc[4], acc[5]); o.w = pack2(acc[6], acc[7]);
    *(uint4*)(QK + (size_t)row * HLD + c0) = o;
  }
}

struct AttnTile { const u16* k; int ldk; const u16* vt; int ldvt; int nvalid; int kpos0; };

template <int DH, class TileFn>
__device__ __forceinline__ void attn_item(const u16* __restrict__ Q, int ldq, int qvalid, u16* __restrict__ O, int ldo, int ntiles,
                          TileFn tf, const float* __restrict__ biasG, int qpos0, float scale, char* smem) {
  constexpr int KLD = DH + 8, NKS = DH / 32, NDT = DH / 16, CPT = DH / 32;
  u16* Ks = (u16*)smem;
  u16* VTs = Ks + 64 * KLD;
  u16* Ps = VTs + DH * 72;
  float* biasS = (float*)(Ps + 4 * 16 * 72);
  int tid = threadIdx.x;
  asm volatile("" : "+v"(tid));
  const int lane = tid & 63, wave = tid >> 6, col = lane & 15, grp = lane >> 4;
  const float L2E = 1.4426950408889634f;
  bf16x8 qf[NKS];
  {
    const int qr = wave * 16 + col;
    const bool ok = qr < qvalid;
#pragma unroll
    for (int ks = 0; ks < NKS; ks++) {
      uint4 w = ok ? *(const uint4*)(Q + (size_t)qr * ldq + ks * 32 + grp * 8) : zero4();
      qf[ks] = *(bf16x8*)&w;
    }
  }
  lds_barrier();
  if (biasG) for (int i = tid; i < 257; i += 256) biasS[i] = biasG[i];
  f32x4 oacc[NDT];
#pragma unroll
  for (int i = 0; i < NDT; i++) oacc[i] = f32x4{0.f, 0.f, 0.f, 0.f};
  float mrun[4], lrun[4];
#pragma unroll
  for (int i = 0; i < 4; i++) { mrun[i] = -INFINITY; lrun[i] = 0.f; }
  uint4 pk_[CPT], pv_[CPT];
  if (DH == 64) {
    const AttnTile T0 = tf(0);
    const int n01 = T0.nvalid - 1;
#pragma unroll
    for (int i = 0; i < CPT; i++) {
      const int c = tid + 256 * i;
      const int key = c / (DH / 8), dc = c % (DH / 8);
      pk_[i] = *(const uint4*)(T0.k + (size_t)min(key, n01) * T0.ldk + dc * 8);
      const int d = c >> 3, kc = c & 7;
      pv_[i] = *(const uint4*)(T0.vt + (size_t)d * T0.ldvt + min(kc * 8, (n01 >> 3) * 8));
    }
  }
#pragma unroll 1
  for (int j = 0; j < ntiles; j++) {
    AttnTile T = tf(j);
    int tidL = tid;
    asm volatile("" : "+v"(tidL));
    lds_barrier();
    const int nvm1 = T.nvalid - 1;
    if (DH == 64) {
#pragma unroll
      for (int i = 0; i < CPT; i++) {
        const int c = tidL + 256 * i;
        const int key = c / (DH / 8), dc = c % (DH / 8);
        *(uint4*)(Ks + key * KLD + dc * 8) = key <= nvm1 ? pk_[i] : zero4();
        const int d = c >> 3, kc = c & 7;
        *(uint4*)(VTs + d * 72 + kc * 8) = (kc * 8 <= nvm1) ? pv_[i] : zero4();
      }
    } else {
      uint4 kv[CPT];
#pragma unroll
      for (int i = 0; i < CPT; i++) {
        const int c = tidL + 256 * i;
        const int key = c / (DH / 8), dc = c % (DH / 8);
        kv[i] = *(const uint4*)(T.k + (size_t)min(key, nvm1) * T.ldk + dc * 8);
      }
#pragma unroll
      for (int i = 0; i < CPT; i++) {
        const int c = tidL + 256 * i;
        const int key = c / (DH / 8), dc = c % (DH / 8);
        *(uint4*)(Ks + key * KLD + dc * 8) = key <= nvm1 ? kv[i] : zero4();
      }
#pragma unroll
      for (int i = 0; i < CPT; i++) {
        const int c = tidL + 256 * i;
        const int d = c >> 3, kc = c & 7;
        kv[i] = *(const uint4*)(T.vt + (size_t)d * T.ldvt + min(kc * 8, (nvm1 >> 3) * 8));
      }
#pragma unroll
      for (int i = 0; i < CPT; i++) {
        const int c = tidL + 256 * i;
        const int d = c >> 3, kc = c & 7;
        *(uint4*)(VTs + d * 72 + kc * 8) = (kc * 8 <= nvm1) ? kv[i] : zero4();
      }
    }
    lds_barrier();
    if (DH == 64 && j + 1 < ntiles) {
      const AttnTile Tn = tf(j + 1);
      const int nn1 = Tn.nvalid - 1;
#pragma unroll
      for (int i = 0; i < CPT; i++) {
        const int c = tidL + 256 * i;
        const int key = c / (DH / 8), dc = c % (DH / 8);
        pk_[i] = *(const uint4*)(Tn.k + (size_t)min(key, nn1) * Tn.ldk + dc * 8);
        const int d = c >> 3, kc = c & 7;
        pv_[i] = *(const uint4*)(Tn.vt + (size_t)d * Tn.ldvt + min(kc * 8, (nn1 >> 3) * 8));
      }
    }
    f32x4 s[4];
#pragma unroll
    for (int n = 0; n < 4; n++) s[n] = f32x4{0.f, 0.f, 0.f, 0.f};
#pragma unroll
    for (int ks = 0; ks < NKS; ks++)
#pragma unroll
      for (int n = 0; n < 4; n++) {
        bf16x8 kf = *(const bf16x8*)(Ks + (n * 16 + col) * KLD + ks * 32 + grp * 8);
        s[n] = MFMA(qf[ks], kf, s[n]);
      }
    float mx[4] = {-INFINITY, -INFINITY, -INFINITY, -INFINITY};
#pragma unroll
    for (int n = 0; n < 4; n++)
#pragma unroll
      for (int i = 0; i < 4; i++) {
        const int key = n * 16 + col;
        float v = s[n][i] * scale;
        if (biasG) {
          int rel = qpos0 + wave * 16 + grp * 4 + i - (T.kpos0 + key);
          rel = min(max(rel, -128), 128) + 128;
          v += biasS[rel];
        }
        if (key >= T.nvalid) v = -INFINITY;
        s[n][i] = v;
        mx[i] = fmaxf(mx[i], v);
      }
    float alpha[4], lsum[4];
#pragma unroll
    for (int i = 0; i < 4; i++) {
      float m2 = fmaxf(mrun[i], row16_max(mx[i]));
      alpha[i] = exp2f((mrun[i] - m2) * L2E);
      mrun[i] = m2;
      lsum[i] = 0.f;
    }
#pragma unroll
    for (int n = 0; n < 4; n++)
#pragma unroll
      for (int i = 0; i < 4; i++) {
        float pv = exp2f((s[n][i] - mrun[i]) * L2E);
        lsum[i] += pv;
        Ps[(wave * 16 + grp * 4 + i) * 72 + n * 16 + col] = f2bf(pv);
      }
#pragma unroll
    for (int i = 0; i < 4; i++) lrun[i] = lrun[i] * alpha[i] + lsum[i];
#pragma unroll
    for (int nd = 0; nd < NDT; nd++)
#pragma unroll
      for (int i = 0; i < 4; i++) oacc[nd][i] *= alpha[i];
    asm volatile("s_waitcnt lgkmcnt(0)" ::: "memory");
#pragma unroll
    for (int k2 = 0; k2 < 2; k2++) {
      bf16x8 pf = *(const bf16x8*)(Ps + (wave * 16 + col) * 72 + k2 * 32 + grp * 8);
#pragma unroll
      for (int nd = 0; nd < NDT; nd++) {
        bf16x8 vf = *(const bf16x8*)(VTs + (nd * 16 + col) * 72 + k2 * 32 + grp * 8);
        oacc[nd] = MFMA(pf, vf, oacc[nd]);
      }
    }
  }
  int rowb = wave * 16 + grp * 4;
  asm volatile("" : "+v"(rowb));
#pragma unroll
  for (int i = 0; i < 4; i++) {
    float l = row16_sum(lrun[i]);
    float inv = __builtin_amdgcn_rcpf(l);
    const int row = rowb + i;
    if (row < qvalid) {
#pragma unroll
      for (int nd = 0; nd < NDT; nd++) O[(size_t)row * ldo + nd * 16 + col] = f2bf(oacc[nd][i] * inv);
    }
  }
}

template <int MODE>
__device__ __forceinline__ void mlstm_item(const Params& p, int item, char* smem) {
  int tid = threadIdx.x;
  asm volatile("" : "+v"(tid));
  const int lane = tid & 63, wave = __builtin_amdgcn_readfirstlane(tid >> 6), col = lane & 15, grp = lane >> 4;
  u16* Z = (u16*)(p.ws + OFF_Z);
  const u16* QK = (const u16*)(p.ws + OFF_H);
  const u16* VBT = (const u16*)(p.ws + OFF_VBT);
  const bool sample = (MODE == 0);
  int h, L, nchunks, row0, bh;
  float *outC = nullptr, *outN = nullptr, *outM = nullptr;
  const u16* CT = nullptr;
  if (MODE == 1) {
    bh = item >> 5; h = bh & 3; L = 64; nchunks = 1; row0 = (bh >> 2) * 2048 + (item & 31) * 64;
    CT = (const u16*)(p.ws + OFF_DELTA) + (size_t)item * 16384;
  } else {
    bh = item; h = bh & 3; L = 32; nchunks = 1; row0 = NP + (bh >> 2) * 32;
    outC = p.out + O_SBC + (size_t)bh * 16384; outN = p.out + O_SBN + bh * 128; outM = p.out + O_SBM + bh;
  }
  u16* Qs = (u16*)smem;
  u16* Ks = Qs + 64 * 136;
  u16* As = Ks;
  u16* KTs = Ks + 64 * 136;
  u16* VTs = KTs + 128 * 72;
  float* fS = (float*)(VTs + 128 * 72);
  float *gS = fS, *MS = fS + 64, *wiS = fS + 128, *emS = fS + 192, *wsS = fS + 256, *denS = fS + 320,
        *ssqS = fS + 384, *nS = fS + 640, *misc = fS + 768;
  f32x4 Cst[8][2];
  const float bif_i = p.b_if[h], bif_f = p.b_if[4 + h];
  lds_barrier();
  if (MODE == 1) {
    if (tid < 128) nS[tid] = ((const float*)(p.ws + OFF_NBUF))[(size_t)item * 128 + tid];
    if (tid == 0) misc[0] = ((const float*)(p.ws + OFF_SCAL))[item * 4 + 2];
  } else if (sample) {
    const float* C0 = p.state_b_C + (size_t)bh * 16384;
    int ibase = grp * 512 + 32 * wave + col;
    asm volatile("" : "+v"(ibase));
#pragma unroll
    for (int mt = 0; mt < 8; mt++)
#pragma unroll
      for (int nn = 0; nn < 2; nn++)
#pragma unroll
        for (int i = 0; i < 4; i++) Cst[mt][nn][i] = C0[(16 * mt + i) * 128 + 16 * nn + ibase];
    if (tid < 128) nS[tid] = p.state_b_n[bh * 128 + tid];
    if (tid == 0) misc[0] = p.state_b_m[bh];
  } else {
#pragma unroll
    for (int mt = 0; mt < 8; mt++)
#pragma unroll
      for (int nn = 0; nn < 2; nn++) Cst[mt][nn] = f32x4{0.f, 0.f, 0.f, 0.f};
    if (tid < 128) nS[tid] = 0.f;
    if (tid == 0) misc[0] = 0.f;
  }
  u16 gpre_i = 0, gpre_f = 0;
  if (wave == 0) {
    const u16* zg = Z + (size_t)(row0 + min(lane, L - 1)) * ZLD + 3584 + h;
    gpre_i = zg[0]; gpre_f = zg[4];
  }
#pragma unroll 1
  for (int c = 0; c < nchunks; c++) {
    int r0 = row0 + c * 64;
    int tidL = tid, colL = col, grpL = grp;
    asm volatile("" : "+v"(r0), "+v"(tidL), "+v"(colL), "+v"(grpL));
    lds_barrier();
    if (wave == 0) {
      const int t = lane;
      float ig = -INFINITY, lf = 0.f;
      {
        const float zi = bf2f(gpre_i) + bif_i, zf = bf2f(gpre_f) + bif_f;
        if (c + 1 < nchunks) {
          const u16* zg = Z + (size_t)(r0 + 64 + t) * ZLD + 3584 + h;
          gpre_i = zg[0]; gpre_f = zg[4];
        }
        if (t < L) {
          ig = zi;
          lf = fminf(zf, 0.f) - log1pf(__expf(-fabsf(zf)));
        }
      }
      float b = lf;
#pragma unroll
      for (int o = 1; o < 64; o <<= 1) { float y = __shfl_up(b, o); if (lane >= o) b += y; }
      const float g = ig - b;
      const float m0 = misc[0];
      float M = g;
#pragma unroll
      for (int o = 1; o < 64; o <<= 1) { float y = __shfl_up(M, o); if (lane >= o) M = fmaxf(M, y); }
      M = fmaxf(M, m0);
      const float Mend = __shfl(M, 63), bl = __shfl(b, 63);
      gS[t] = g; MS[t] = M; wiS[t] = __expf(m0 - M); emS[t] = __expf(-(b + M)); wsS[t] = __expf(g - Mend);
      if (lane == 0) { misc[1] = __expf(m0 - Mend); misc[2] = bl + Mend; }
    }
    lds_barrier();
    {
      uint4 qv[4], kv[4], vv[4];
      const int Lm1 = L - 1;
      const int s_ = tidL & 63;
#pragma unroll
      for (int i = 0; i < 4; i++) {
        const int ci = tidL + 256 * i;
        const int t = ci >> 4, dc = ci & 15;
        qv[i] = *(const uint4*)(QK + (size_t)(r0 + min(t, Lm1)) * HLD + h * 128 + dc * 8);
        const int dk = (tidL >> 6) + 4 * i;
        kv[i] = *(const uint4*)(QK + (size_t)(r0 + min(s_, Lm1)) * HLD + 512 + h * 128 + dk * 8);
        const int vd = ci >> 3, sc = ci & 7;
        vv[i] = *(const uint4*)(VBT + (size_t)(h * 128 + vd) * VLD + r0 + min(sc * 8, (Lm1 >> 3) * 8));
      }
      const float wsv = wsS[s_];
#pragma unroll
      for (int i = 0; i < 4; i++) {
        const int ci = tidL + 256 * i;
        const int t = ci >> 4, dc = ci & 15;
        *(uint4*)(Qs + t * 136 + dc * 8) = t <= Lm1 ? qv[i] : zero4();
        const int dk = (tidL >> 6) + 4 * i;
        const uint4 v = s_ <= Lm1 ? kv[i] : zero4();
        *(uint4*)(Ks + s_ * 136 + dk * 8) = v;
        const u32 w[4] = {v.x, v.y, v.z, v.w};
#pragma unroll
        for (int e = 0; e < 4; e++) {
          KTs[(dk * 8 + 2 * e) * 72 + s_] = f2bf(lo16(w[e]) * wsv);
          KTs[(dk * 8 + 2 * e + 1) * 72 + s_] = f2bf(hi16(w[e]) * wsv);
        }
        const int vd = ci >> 3, sc = ci & 7;
        *(uint4*)(VTs + vd * 72 + sc * 8) = (sc * 8 <= Lm1) ? vv[i] : zero4();
      }
    }
    lds_barrier();
    f32x4 sacc[4];
#pragma unroll
    for (int n = 0; n < 4; n++) sacc[n] = f32x4{0.f, 0.f, 0.f, 0.f};
#pragma unroll
    for (int ks = 0; ks < 4; ks++) {
      bf16x8 qa = *(const bf16x8*)(Qs + (wave * 16 + col) * 136 + ks * 32 + grp * 8);
#pragma unroll
      for (int n = 0; n < 4; n++)
        if (n <= wave) {
          bf16x8 kb = *(const bf16x8*)(Ks + (n * 16 + col) * 136 + ks * 32 + grp * 8);
          sacc[n] = MFMA(qa, kb, sacc[n]);
        }
    }
#pragma unroll
    for (int n = 0; n < 4; n++)
#pragma unroll
      for (int i = 0; i < 4; i++) {
        const int t = wave * 16 + grp * 4 + i, s = n * 16 + col;
        const float dec = __expf(gS[s] - MS[t]);
        sacc[n][i] = (s <= t) ? sacc[n][i] * dec : 0.f;
      }
    lds_barrier();
#pragma unroll
    for (int n = 0; n < 4; n++)
#pragma unroll
      for (int i = 0; i < 4; i++) As[(wave * 16 + grp * 4 + i) * 72 + n * 16 + col] = f2bf(sacc[n][i]);
    lds_barrier();
    {
      f32x4 d1 = f32x4{0.f, 0.f, 0.f, 0.f}, d2 = f32x4{0.f, 0.f, 0.f, 0.f};
      const u32 one2 = (col == 0) ? 0x3F803F80u : 0u;
      uint4 ow = make_uint4(one2, one2, one2, one2);
      bf16x8 ones = *(bf16x8*)&ow;
#pragma unroll
      for (int ks = 0; ks < 2; ks++)
        if (ks == 0 || wave >= 2) {
          bf16x8 aa = *(const bf16x8*)(As + (wave * 16 + col) * 72 + ks * 32 + grp * 8);
          d1 = MFMA(aa, ones, d1);
        }
#pragma unroll
      for (int ks = 0; ks < 4; ks++) {
        uint4 w = zero4();
        if (col == 0) {
          const float* np_ = nS + ks * 32 + grp * 8;
          w.x = pack2(np_[0], np_[1]); w.y = pack2(np_[2], np_[3]); w.z = pack2(np_[4], np_[5]); w.w = pack2(np_[6], np_[7]);
        }
        bf16x8 nf = *(bf16x8*)&w;
        bf16x8 qa = *(const bf16x8*)(Qs + (wave * 16 + col) * 136 + ks * 32 + grp * 8);
        d2 = MFMA(qa, nf, d2);
      }
      if (col == 0) {
#pragma unroll
        for (int i = 0; i < 4; i++) { const int t = wave * 16 + grp * 4 + i; denS[t] = d1[i] + wiS[t] * d2[i]; }
      }
    }
    lds_barrier();
    bf16x8 cb[4][2];
#pragma unroll
    for (int j = 0; j < 4; j++)
#pragma unroll
      for (int nn = 0; nn < 2; nn++) {
        uint4 w;
        if (MODE == 1) {
          w = *(const uint4*)(CT + (size_t)(32 * wave + 16 * nn + col) * 128 + 32 * j + grp * 8);
        } else {
          w.x = pack2(Cst[2 * j][nn][0], Cst[2 * j][nn][1]);
          w.y = pack2(Cst[2 * j][nn][2], Cst[2 * j][nn][3]);
          w.z = pack2(Cst[2 * j + 1][nn][0], Cst[2 * j + 1][nn][1]);
          w.w = pack2(Cst[2 * j + 1][nn][2], Cst[2 * j + 1][nn][3]);
        }
        cb[j][nn] = *(bf16x8*)&w;
      }
    u32 hreg[4][4];
#pragma unroll
    for (int m = 0; m < 4; m++) {
      f32x4 av[2], qc[2];
#pragma unroll
      for (int nn = 0; nn < 2; nn++) { av[nn] = f32x4{0.f, 0.f, 0.f, 0.f}; qc[nn] = f32x4{0.f, 0.f, 0.f, 0.f}; }
#pragma unroll
      for (int ks = 0; ks < 2; ks++)
        if (ks == 0 || m >= 2) {
          bf16x8 aa = *(const bf16x8*)(As + (m * 16 + col) * 72 + ks * 32 + grp * 8);
#pragma unroll
          for (int nn = 0; nn < 2; nn++) {
            bf16x8 vb = *(const bf16x8*)(VTs + (32 * wave + 16 * nn + col) * 72 + ks * 32 + grp * 8);
            av[nn] = MFMA(aa, vb, av[nn]);
          }
        }
#pragma unroll
      for (int j = 0; j < 4; j++) {
        uint4 w;
        if (MODE == 1) {
          w = *(const uint4*)(Qs + (m * 16 + col) * 136 + 32 * j + 8 * grp);
        } else {
          uint2 a0 = *(const uint2*)(Qs + (m * 16 + col) * 136 + 32 * j + 4 * grp);
          uint2 a1 = *(const uint2*)(Qs + (m * 16 + col) * 136 + 32 * j + 16 + 4 * grp);
          w = make_uint4(a0.x, a0.y, a1.x, a1.y);
        }
        bf16x8 qp = *(bf16x8*)&w;
#pragma unroll
        for (int nn = 0; nn < 2; nn++) qc[nn] = MFMA(qp, cb[j][nn], qc[nn]);
      }
#pragma unroll
      for (int i = 0; i < 4; i++) {
        const int t = m * 16 + grp * 4 + i;
        const float wi = wiS[t];
        const float inv = 1.f / fmaxf(fabsf(denS[t]), emS[t]);
        const float hv0 = (av[0][i] + wi * qc[0][i]) * inv, hv1 = (av[1][i] + wi * qc[1][i]) * inv;
        hreg[m][i] = pack2(hv0, hv1);
        float s2 = hv0 * hv0 + hv1 * hv1;
        s2 = row16_sum(s2);
        if (col == 0) ssqS[wave * 64 + t] = s2;
      }
    }
    lds_barrier();
    {
      u32 obv[4][4];
      float gh[2];
#pragma unroll
      for (int nn = 0; nn < 2; nn++) gh[nn] = p.g_head[h * 128 + 32 * wave + 16 * nn + colL];
#pragma unroll
      for (int m = 0; m < 4; m++)
#pragma unroll
        for (int i = 0; i < 4; i++) {
          const int t = m * 16 + grpL * 4 + i;
          const u16* zp = Z + (size_t)(r0 + min(t, L - 1)) * ZLD + 3072 + h * 128 + 32 * wave + colL;
          obv[m][i] = (u32)zp[0] | ((u32)zp[16] << 16);
        }
#pragma unroll
      for (int m = 0; m < 4; m++)
#pragma unroll
        for (int i = 0; i < 4; i++) {
          const int t = m * 16 + grpL * 4 + i;
          if (t < L) {
            const float tot = ssqS[t] + ssqS[64 + t] + ssqS[128 + t] + ssqS[192 + t];
            const float r = rsqrtf(tot * (1.f / 128.f) + 1e-6f);
#pragma unroll
            for (int nn = 0; nn < 2; nn++) {
              const int vd = 32 * wave + 16 * nn + colL;
              const float o = (nn ? hi16(hreg[m][i]) : lo16(hreg[m][i])) * r * gh[nn] * sigmoidf_(nn ? hi16(obv[m][i]) : lo16(obv[m][i]));
              Z[(size_t)(r0 + t) * ZLD + 2560 + h * 128 + vd] = f2bf(o);
            }
          }
        }
    }
    if (MODE == 0) {
    const float a0 = misc[1];
#pragma unroll
    for (int mt = 0; mt < 8; mt++)
#pragma unroll
      for (int nn = 0; nn < 2; nn++)
#pragma unroll
        for (int i = 0; i < 4; i++) Cst[mt][nn][i] *= a0;
#pragma unroll
    for (int ks = 0; ks < 2; ks++)
#pragma unroll
      for (int nn = 0; nn < 2; nn++) {
        bf16x8 vb = *(const bf16x8*)(VTs + (32 * wave + 16 * nn + col) * 72 + ks * 32 + grp * 8);
#pragma unroll
        for (int mt = 0; mt < 8; mt++) {
          bf16x8 ka = *(const bf16x8*)(KTs + (mt * 16 + col) * 72 + ks * 32 + grp * 8);
          Cst[mt][nn] = MFMA(ka, vb, Cst[mt][nn]);
        }
      }
    if (tid < 128) {
      float acc = 0.f;
#pragma unroll
      for (int s8 = 0; s8 < 8; s8++) {
        uint4 v = *(const uint4*)(KTs + tid * 72 + s8 * 8);
        acc += lo16(v.x) + hi16(v.x) + lo16(v.y) + hi16(v.y) + lo16(v.z) + hi16(v.z) + lo16(v.w) + hi16(v.w);
      }
      nS[tid] = a0 * nS[tid] + acc;
    }
    if (tid == 0) misc[0] = misc[2];
    }
  }
  lds_barrier();
  if (MODE == 1) return;
  int obase = grp * 512 + 32 * wave + col;
  asm volatile("" : "+v"(obase));
#pragma unroll
  for (int mt = 0; mt < 8; mt++)
#pragma unroll
    for (int nn = 0; nn < 2; nn++)
#pragma unroll
      for (int i = 0; i < 4; i++) outC[(16 * mt + i) * 128 + 16 * nn + obase] = Cst[mt][nn][i];
  if (tid < 128) outN[tid] = nS[tid];
  if (tid == 0) *outM = misc[0];
}

__device__ __forceinline__ void mlstm_delta_item(const Params& p, int item, char* smem) {
  int tid = threadIdx.x;
  asm volatile("" : "+v"(tid));
  const int lane = tid & 63, wave = __builtin_amdgcn_readfirstlane(tid >> 6), col = lane & 15, grp = lane >> 4;
  const int wr = wave >> 1, wc = wave & 1;
  const u16* Z = (const u16*)(p.ws + OFF_Z);
  const u16* QK = (const u16*)(p.ws + OFF_H);
  const u16* VBT = (const u16*)(p.ws + OFF_VBT);
  const int bh = item >> 5, h = bh & 3;
  const int r0 = (bh >> 2) * 2048 + (item & 31) * 64;
  u16* T = (u16*)smem;
  u16* KTs = T + 128 * TLD;
  u16* VTs = KTs + 128 * 72;
  float* wsS = (float*)(VTs + 128 * 72);
  lds_barrier();
  if (wave == 0) {
    const u16* zg = Z + (size_t)(r0 + lane) * ZLD + 3584 + h;
    const u16 zi16 = zg[0], zf16 = zg[4];
    const float ig = bf2f(zi16) + p.b_if[h], zf = bf2f(zf16) + p.b_if[4 + h];
    const float lf = fminf(zf, 0.f) - log1pf(__expf(-fabsf(zf)));
    float b = lf;
#pragma unroll
    for (int o = 1; o < 64; o <<= 1) { float y = __shfl_up(b, o); if (lane >= o) b += y; }
    const float g = ig - b;
    float gm = g;
#pragma unroll
    for (int o = 32; o >= 1; o >>= 1) gm = fmaxf(gm, __shfl_xor(gm, o));
    wsS[lane] = __expf(g - gm);
    if (lane == 63) {
      float* sc = (float*)(p.ws + OFF_SCAL) + item * 4;
      sc[0] = b; sc[1] = gm;
    }
  }
  lds_barrier();
  uint4 kv[4], vv[4];
  const int s_ = tid & 63;
#pragma unroll
  for (int i = 0; i < 4; i++) {
    const int dk = (tid >> 6) + 4 * i;
    kv[i] = *(const uint4*)(QK + (size_t)(r0 + s_) * HLD + 512 + h * 128 + dk * 8);
    const int ci = tid + 256 * i;
    vv[i] = *(const uint4*)(VBT + (size_t)(h * 128 + (ci >> 3)) * VLD + r0 + (ci & 7) * 8);
  }
  const float wsv = wsS[s_];
#pragma unroll
  for (int i = 0; i < 4; i++) {
    const int dk = (tid >> 6) + 4 * i;
    const u32 w[4] = {kv[i].x, kv[i].y, kv[i].z, kv[i].w};
#pragma unroll
    for (int e = 0; e < 4; e++) {
      KTs[(dk * 8 + 2 * e) * 72 + s_] = f2bf(lo16(w[e]) * wsv);
      KTs[(dk * 8 + 2 * e + 1) * 72 + s_] = f2bf(hi16(w[e]) * wsv);
    }
    const int ci = tid + 256 * i;
    *(uint4*)(VTs + (ci >> 3) * 72 + (ci & 7) * 8) = vv[i];
  }
  lds_barrier();
  f32x4 acc[4][4];
  ACC_ZERO(acc);
#pragma unroll
  for (int ks = 0; ks < 2; ks++) {
    bf16x8 af[4], bq[4];
#pragma unroll
    for (int m = 0; m < 4; m++) af[m] = *(const bf16x8*)(VTs + (wr * 64 + m * 16 + col) * 72 + ks * 32 + grp * 8);
#pragma unroll
    for (int n = 0; n < 4; n++) bq[n] = *(const bf16x8*)(KTs + (wc * 64 + n * 16 + col) * 72 + ks * 32 + grp * 8);
#pragma unroll
    for (int m = 0; m < 4; m++)
#pragma unroll
      for (int n = 0; n < 4; n++) acc[m][n] = MFMA(af[m], bq[n], acc[m][n]);
  }
  if (tid < 128) {
    float a = 0.f;
#pragma unroll
    for (int s8 = 0; s8 < 8; s8++) {
      uint4 v = *(const uint4*)(KTs + tid * 72 + s8 * 8);
      a += lo16(v.x) + hi16(v.x) + lo16(v.y) + hi16(v.y) + lo16(v.z) + hi16(v.z) + lo16(v.w) + hi16(v.w);
    }
    ((float*)(p.ws + OFF_NBUF))[(size_t)item * 128 + tid] = a;
  }
  u16* D = (u16*)(p.ws + OFF_DELTA) + (size_t)item * 16384;
  epi_stage<false>(acc, T);
  EPI_CHUNKS(T, { *(uint4*)(D + r * 128 + c8) = v; })
}

__device__ __forceinline__ void mlstm_scan(const Params& p) {
  const int tid = threadIdx.x;
  float* SC = (float*)(p.ws + OFF_SCAL);
  for (int it = blockIdx.x; it < 256; it += gridDim.x) {
    const int bh = it >> 3, sl = it & 7;
    u16* D = (u16*)(p.ws + OFF_DELTA) + (size_t)bh * 32 * 16384 + sl * 2048 + tid * 8;
    float* NB = (float*)(p.ws + OFF_NBUF) + (size_t)bh * 32 * 128;
    float st[8], nst = 0.f, m0 = 0.f;
#pragma unroll
    for (int e = 0; e < 8; e++) st[e] = 0.f;
    uint4 cur = *(const uint4*)D;
    float ncur = (sl == 0 && tid < 128) ? NB[tid] : 0.f;
    float2 sc = *(const float2*)(SC + (bh * 32) * 4);
#pragma unroll 1
    for (int c = 0; c < 32; c++) {
      uint4 nxt = cur; float nnxt = ncur; float2 scn = sc;
      if (c + 1 < 32) {
        nxt = *(const uint4*)(D + (size_t)(c + 1) * 16384);
        if (sl == 0 && tid < 128) nnxt = NB[(c + 1) * 128 + tid];
        scn = *(const float2*)(SC + (bh * 32 + c + 1) * 4);
      }
      uint4 o;
      o.x = pack2(st[0], st[1]); o.y = pack2(st[2], st[3]); o.z = pack2(st[4], st[5]); o.w = pack2(st[6], st[7]);
      *(uint4*)(D + (size_t)c * 16384) = o;
      if (sl == 0) {
        if (tid < 128) NB[c * 128 + tid] = nst;
        if (tid == 0) SC[(bh * 32 + c) * 4 + 2] = m0;
      }
      const float bl = sc.x, gm = sc.y;
      const float mx = fmaxf(m0, gm);
      const float al = __expf(m0 - mx), be = __expf(gm - mx);
      st[0] = al * st[0] + be * lo16(cur.x); st[1] = al * st[1] + be * hi16(cur.x);
      st[2] = al * st[2] + be * lo16(cur.y); st[3] = al * st[3] + be * hi16(cur.y);
      st[4] = al * st[4] + be * lo16(cur.z); st[5] = al * st[5] + be * hi16(cur.z);
      st[6] = al * st[6] + be * lo16(cur.w); st[7] = al * st[7] + be * hi16(cur.w);
      nst = al * nst + be * ncur;
      m0 = bl + mx;
      cur = nxt; ncur = nnxt; sc = scn;
    }
    const int vd = sl * 16 + (tid >> 4), kd0 = (tid & 15) * 8;
    float* oc = p.out + O_PBC + (size_t)bh * 16384;
#pragma unroll
    for (int e = 0; e < 8; e++) oc[(kd0 + e) * 128 + vd] = st[e];
    if (sl == 0) {
      if (tid < 128) p.out[O_PBN + bh * 128 + tid] = nst;
      if (tid == 0) p.out[O_PBM + bh] = m0;
    }
  }
}

__device__ __forceinline__ void phase_mixers(const Params& p, char* smem, int* s_item) {
  char* ws = p.ws;
  u16* Z = (u16*)(ws + OFF_Z);
  const u16* VAT = (const u16*)(ws + OFF_VAT);
  const int tid = threadIdx.x;
  {
    const size_t gs = (size_t)gridDim.x * 256, g0 = (size_t)blockIdx.x * 256 + tid;
    for (size_t i = g0; i < 2097152; i += gs) {
      int f = i & 511; int r = (i >> 9) & 511; int b = i >> 18;
      p.out[O_PAK + i] = bf2f(Z[(size_t)(b * 2048 + 1536 + r) * ZLD + 512 + f]);
    }
    for (size_t i = g0; i < 2097152; i += gs) {
      int r = i & 511; int f = (i >> 9) & 511; int b = i >> 18;
      p.out[O_PAV + ((size_t)(b * 512 + r) * 512 + f)] = bf2f(VAT[(size_t)f * VLD + b * 2048 + 1536 + r]);
    }
    for (size_t i = g0; i < 262144; i += gs) {
      int f = i & 511; int r = i >> 9;
      p.out[O_SAK + i] = bf2f(Z[(size_t)(NP + r) * ZLD + 512 + f]);
    }
    for (size_t i = g0; i < 262144; i += gs) {
      int r = i & 511; int f = i >> 9;
      p.out[O_SAV + (size_t)r * 512 + f] = bf2f(VAT[(size_t)f * VLD + NP + r]);
    }
    for (size_t i = g0; i < 24576; i += gs) {
      int c = i & 1023; int j = (i >> 10) % 3; int b = i / 3072;
      p.out[O_PBCONV + i] = bf2f(Z[(size_t)(b * 2048 + 2045 + j) * ZLD + 1536 + c]);
    }
    for (size_t i = g0; i < 49152; i += gs) {
      int c = i & 1023; int j = (i >> 10) % 3; int sb = i / 3072;
      p.out[O_SBCONV + i] = bf2f(Z[(size_t)(NP + sb * 32 + 29 + j) * ZLD + 1536 + c]);
    }
  }
  int* ctr = (int*)(ws + OFF_CTR);
  const int total = 1088 + 2048 + 128;
  for (;;) {
    __syncthreads();
    if (tid == 0) *s_item = atomicAdd(ctr, 1);
    __syncthreads();
    const int it = __builtin_amdgcn_readfirstlane(*s_item);
    if (it >= total) break;
    if (it < 1024) {
      mlstm_delta_item(p, it, smem);
    } else if (it < 1088) {
      mlstm_item<0>(p, it - 1024, smem);
    } else if (it < 1088 + 2048) {
      const int q = it - 1088;
      const int h = q & 7, c = (q >> 3) & 31, b = q >> 8;
      const int nb = c < 8 ? c : 8;
      u16* Qp = Z + (size_t)(b * 2048 + c * 64) * ZLD + h * 64;
      auto tf = [=](int j) {
        const int cc = c - nb + j;
        AttnTile T;
        T.k = Z + (size_t)(b * 2048 + cc * 64) * ZLD + 512 + h * 64; T.ldk = ZLD;
        T.vt = VAT + (size_t)(h * 64) * VLD + b * 2048 + cc * 64; T.ldvt = VLD;
        T.nvalid = 64; T.kpos0 = cc * 64;
        return T;
      };
      attn_item<64>(Qp, ZLD, 64, Qp, ZLD, nb + 1, tf, p.rel_bias + h * 257, c * 64, 0.125f, smem);
    } else {
      const int q = it - 1088 - 2048;
      const int h = q & 7, sb = q >> 3;
      const u16* KC = (const u16*)(ws + OFF_KC);
      const u16* VCT = (const u16*)(ws + OFF_VCT);
      u16* Qp = Z + (size_t)(NP + sb * 32) * ZLD + h * 64;
      auto tf = [=](int j) {
        AttnTile T;
        if (j < 8) {
          T.k = KC + (size_t)(sb * 512 + j * 64) * 512 + h * 64; T.ldk = 512;
          T.vt = VCT + (size_t)(sb * 512 + h * 64) * 512 + j * 64; T.ldvt = 512;
          T.nvalid = 64; T.kpos0 = j * 64;
        } else {
          T.k = Z + (size_t)(NP + sb * 32) * ZLD + 512 + h * 64; T.ldk = ZLD;
          T.vt = VAT + (size_t)(h * 64) * VLD + NP + sb * 32; T.ldvt = VLD;
          T.nvalid = 32; T.kpos0 = 512;
        }
        return T;
      };
      attn_item<64>(Qp, ZLD, 32, Qp, ZLD, 9, tf, p.rel_bias + h * 257, 512, 0.125f, smem);
    }
  }
}

__device__ __forceinline__ void phase_mlstm_out(const Params& p, char* smem) {
  for (int it = blockIdx.x; it < 1024; it += gridDim.x) mlstm_item<1>(p, it, smem);
}

__device__ __forceinline__ void phase_mixed(const Params& p, char* smem) {
  char* ws = p.ws;
  const u16* Z = (const u16*)(ws + OFF_Z);
  const u16* G = (const u16*)p.out;
  u16* Hm = (u16*)(ws + OFF_H);
  const int xcd = blockIdx.x & 7, slot = blockIdx.x >> 3, nslots = gridDim.x >> 3;
#pragma unroll 1
  for (int j = slot;; j += nslots) {
    int mt, nt;
    if (!sched_tile(132, 8, xcd, j, mt, nt)) break;
    const int m0 = mt * 128, n0 = nt * 128;
    f32x4 acc[4][4];
    ACC_ZERO(acc);
    gemm_tile(Z, ZLD, (const u16*)(ws + OFF_WT_AUP), WLD5, 512, m0, n0, (u16*)smem, acc);
    {
      u16* T = (u16*)smem;
      epi_stage<false>(acc, T);
      EPI_CHUNKS(T, {
        const int row = m0 + r;
        const uint4 g = *(const uint4*)(G + (size_t)row * 2048 + ((n0 + (row & 15) * 128) & 2047) + c8);
        uint4 o;
        o.x = pack2(lo16(v.x) * sigmoidf_(lo16(g.x)), hi16(v.x) * sigmoidf_(hi16(g.x)));
        o.y = pack2(lo16(v.y) * sigmoidf_(lo16(g.y)), hi16(v.y) * sigmoidf_(hi16(g.y)));
        o.z = pack2(lo16(v.z) * sigmoidf_(lo16(g.z)), hi16(v.z) * sigmoidf_(hi16(g.z)));
        o.w = pack2(lo16(v.w) * sigmoidf_(lo16(g.w)), hi16(v.w) * sigmoidf_(hi16(g.w)));
        *(uint4*)(Hm + (size_t)row * HLD + n0 + c8) = o;
      })
    }
  }
#pragma unroll 1
  for (int j = slot;; j += nslots) {
    int mt, nt;
    if (!sched_tile(132, 8, xcd, j, mt, nt)) break;
    const int m0 = mt * 128, n0 = nt * 128;
    f32x4 acc[4][4];
    ACC_ZERO(acc);
    gemm_tile(Z + 2560, ZLD, (const u16*)(ws + OFF_WT_BUP), WLD5, 512, m0, n0, (u16*)smem, acc);
    {
      u16* T = (u16*)smem;
      epi_stage<false>(acc, T);
      EPI_CHUNKS(T, {
        const int row = m0 + r;
        const uint4 g = *(const uint4*)(G + (size_t)row * 2048 + ((1024 + n0 + (row & 15) * 128) & 2047) + c8);
        const uint4 hp = *(const uint4*)(Hm + (size_t)row * HLD + n0 + c8);
        uint4 o;
        o.x = pack2(lo16(hp.x) + lo16(v.x) * sigmoidf_(lo16(g.x)), hi16(hp.x) + hi16(v.x) * sigmoidf_(hi16(g.x)));
        o.y = pack2(lo16(hp.y) + lo16(v.y) * sigmoidf_(lo16(g.y)), hi16(hp.y) + hi16(v.y) * sigmoidf_(hi16(g.y)));
        o.z = pack2(lo16(hp.z) + lo16(v.z) * sigmoidf_(lo16(g.z)), hi16(hp.z) + hi16(v.z) * sigmoidf_(hi16(g.z)));
        o.w = pack2(lo16(hp.w) + lo16(v.w) * sigmoidf_(lo16(g.w)), hi16(hp.w) + hi16(v.w) * sigmoidf_(hi16(g.w)));
        *(uint4*)(Hm + (size_t)row * HLD + n0 + c8) = o;
      })
    }
  }
  cvt_fp8(p.peer_u, (unsigned char*)(ws + OFF_PU), 16384ull * 1024, 64.f);
  cvt_fp8(p.peer_v, (unsigned char*)(ws + OFF_PU) + 1024, 16384ull * 1024, 16.f);
}

__device__ __forceinline__ void phase_gemm_generic(const Params& p, char* smem, const u16* A, const u16* Bt, int ntn, int mode, u16* dst,
                                   int ldd) {
  float* y = p.out;
  const int xcd = blockIdx.x & 7, slot = blockIdx.x >> 3, nslots = gridDim.x >> 3;
#pragma unroll 1
  for (int j = slot;; j += nslots) {
    int mt, nt;
    if (!sched_tile(132, ntn, xcd, j, mt, nt)) break;
    const int m0 = mt * 128, n0 = nt * 128;
    f32x4 acc[4][4];
    ACC_ZERO(acc);
    gemm_tile(A, HLD, Bt, HLD, 1024, m0, n0, (u16*)smem, acc);
    if (mode == 0 || mode == 1) {
      const float* xin = (mode == 1) ? y : (m0 < NP ? p.x_prompt : p.x_sample - (size_t)NP * 1024);
      _Pragma("unroll") for (int mh = 0; mh < 2; mh++) {
        float xv[2][4][4];
        EPI_LOOP(acc, m0, n0, {
          if ((m >> 1) == mh) { _Pragma("unroll") for (int j = 0; j < 4; j++) xv[m & 1][n][j] = xin[(size_t)(row + j) * 1024 + colg]; }
        })
        EPI_LOOP(acc, m0, n0, {
          if ((m >> 1) == mh) { _Pragma("unroll") for (int j = 0; j < 4; j++) y[(size_t)(row + j) * 1024 + colg] = xv[m & 1][n][j] + v[j]; }
        })
      }
    } else {
      u16* T = (u16*)smem;
      epi_stage<false>(acc, T);
      EPI_CHUNKS(T, { *(uint4*)(dst + (size_t)(m0 + r) * ldd + n0 + c8) = v; })
    }
  }
}

__device__ __forceinline__ void phase_norm(const Params& p, const float* g) {
  const int lane = threadIdx.x & 63, gw = blockIdx.x * 4 + (threadIdx.x >> 6), nw = gridDim.x * 4;
  for (int r = gw; r < NT; r += nw)
    rms_row_to_bf16(p.out + (size_t)r * 1024, g, (u16*)(p.ws + OFF_H) + (size_t)r * HLD, lane);
}

__device__ __forceinline__ void phase_cross(const Params& p, char* smem) {
  char* ws = p.ws;
  u16* QC = (u16*)(ws + OFF_QC);
  const u16* MK = (const u16*)(ws + OFF_MK);
  const u16* MVT = (const u16*)(ws + OFF_MVT);
  for (int it = blockIdx.x; it < 1024 + 64; it += gridDim.x) {
    int bb, tile, h, row0, qv;
    if (it < 1024) { h = it & 3; tile = (it >> 2) & 31; bb = it >> 7; row0 = bb * 2048 + tile * 64; qv = 64; }
    else { int q = it - 1024; h = q & 3; bb = 8 + (q >> 2); row0 = NP + (bb - 8) * 32; qv = 32; }
    u16* Qp = QC + (size_t)row0 * HLD + h * 256;
    auto tf = [=](int j) {
      AttnTile T;
      T.k = MK + (size_t)(bb * 256 + j * 64) * HLD + h * 256; T.ldk = HLD;
      T.vt = MVT + ((size_t)bb * 1024 + h * 256) * 256 + j * 64; T.ldvt = 256;
      T.nvalid = 64; T.kpos0 = 0;
      return T;
    };
    attn_item<256>(Qp, HLD, qv, Qp, HLD, 4, tf, nullptr, 0, 0.0625f, smem);
  }
}

__constant__ unsigned char STAIR[64] = {
    0x00, 0x01, 0x02, 0x03, 0x04, 0x05, 0x06, 0x07, 0x08, 0x09, 0x0A, 0x0B, 0x0C, 0x0D, 0x0E, 0x0F,
    0x10, 0x11, 0x12, 0x13, 0x14, 0x15, 0x16, 0x17,
    0x20, 0x21, 0x22, 0x23, 0x24,
    0x30, 0x31, 0x32, 0x33,
    0x40, 0x41, 0x42,
    0x50, 0x51, 0x60, 0x61, 0x70, 0x71,
    0x80, 0x90, 0xA0, 0xB0, 0xC0, 0xD0, 0xE0, 0xF0,
    0xFF, 0xFF, 0xFF, 0xFF, 0xFF, 0xFF, 0xFF, 0xFF, 0xFF, 0xFF, 0xFF, 0xFF, 0xFF, 0xFF};

#define INS16(L, x)                                                        \
  _Pragma("unroll") for (int _q = 0; _q < 16; _q++) {                       \
    const u32 _hi = umax2(L[_q], x);                                        \
    x = L[_q] < x ? L[_q] : x;                                              \
    L[_q] = _hi;                                                            \
  }
__device__ __forceinline__ void phase_route(const Params& p, char* smem) {
  char* ws = p.ws;
  const u16* PQ = (const u16*)(ws + OFF_PQ);
  const u16* SUBK = (const u16*)(ws + OFF_SUBK);
  float2* ROUTE = (float2*)(ws + OFF_ROUTE);
  int tid = threadIdx.x;
  asm volatile("" : "+v"(tid));
  const int lane = tid & 63, wave = __builtin_amdgcn_readfirstlane(tid >> 6), col = lane & 15, grp = lane >> 4;
  u16* keyS = (u16*)smem;
  u32* listS = (u32*)smem;
  u32* stairS = (u32*)(smem + 66560);
  int* cntS = (int*)(smem + 66560 + 256);
  if (tid < 64) stairS[tid] = STAIR[tid];
#pragma unroll 1
  for (int it = blockIdx.x; it < NT / 16; it += gridDim.x) {
    const int tok0 = it * 16;
    __syncthreads();
#pragma unroll 1
    for (int q = 0; q < 4; q++) {
      const int hc = wave * 4 + q;
      f32x4 acc[8];
#pragma unroll
      for (int nt = 0; nt < 8; nt++) acc[nt] = f32x4{0.f, 0.f, 0.f, 0.f};
#pragma unroll
      for (int ks = 0; ks < 4; ks++) {
        bf16x8 a = *(const bf16x8*)(PQ + (size_t)(tok0 + col) * PQLD + hc * 128 + ks * 32 + grp * 8);
#pragma unroll
        for (int nt = 0; nt < 8; nt++) {
          bf16x8 bb = *(const bf16x8*)(SUBK + (size_t)(hc * 128 + nt * 16 + col) * 128 + ks * 32 + grp * 8);
          acc[nt] = MFMA(a, bb, acc[nt]);
        }
      }
#pragma unroll
      for (int nt = 0; nt < 8; nt++)
#pragma unroll
        for (int i = 0; i < 4; i++)
          keyS[((grp * 4 + i) * 16 + hc) * 130 + nt * 16 + col] = (u16)(ordk(acc[nt][i]) >> 16);
    }
    __syncthreads();
    u32 L[16];
#pragma unroll
    for (int q = 0; q < 16; q++) L[q] = 0u;
    {
      const u32* rowp = (const u32*)(keyS + tid * 130);
#pragma unroll 4
      for (int j2 = 0; j2 < 64; j2++) {
        const u32 w = rowp[j2];
        u32 x0 = (w << 16) | (u32)(127 - 2 * j2);
        u32 x1 = (w & 0xffff0000u) | (u32)(126 - 2 * j2);
        INS16(L, x0)
        INS16(L, x1)
      }
    }
    __syncthreads();
#pragma unroll
    for (int q = 0; q < 4; q++)
      *(uint4*)(listS + tid * 16 + q * 4) = make_uint4(L[4 * q], L[4 * q + 1], L[4 * q + 2], L[4 * q + 3]);
    __syncthreads();
    int eidx[16];
    float gate[16];
    if (tid < 128) {
      const int token = tid >> 3, head = tid & 7;
      const u32* la = listS + (token * 16 + head * 2) * 16;
      const u32* lb = la + 16;
      float av[16], bv[16];
#pragma unroll
      for (int q = 0; q < 4; q++) {
        const uint4 wa = *(const uint4*)(la + 4 * q), wb = *(const uint4*)(lb + 4 * q);
        av[4 * q] = unordk(wa.x & 0xffff0000u); av[4 * q + 1] = unordk(wa.y & 0xffff0000u);
        av[4 * q + 2] = unordk(wa.z & 0xffff0000u); av[4 * q + 3] = unordk(wa.w & 0xffff0000u);
        bv[4 * q] = unordk(wb.x & 0xffff0000u); bv[4 * q + 1] = unordk(wb.y & 0xffff0000u);
        bv[4 * q + 2] = unordk(wb.z & 0xffff0000u); bv[4 * q + 3] = unordk(wb.w & 0xffff0000u);
      }
      u32 T[16];
#pragma unroll
      for (int q = 0; q < 16; q++) T[q] = 0u;
      {
        int slot = 0;
#pragma unroll
        for (int ia = 0; ia < 16; ia++)
#pragma unroll
          for (int ib = 0; ib < 16; ib++)
            if ((ia + 1) * (ib + 1) <= 16) {
              u32 x = (ordk(av[ia] + bv[ib]) & ~63u) | (u32)(63 - slot);
              INS16(T, x)
              slot++;
            }
      }
      float e[16], ssum = 0.f;
      const float vmax = unordk(T[0] & ~63u);
#pragma unroll
      for (int k = 0; k < 16; k++) { e[k] = __expf(unordk(T[k] & ~63u) - vmax); ssum += e[k]; }
      const float rs = __builtin_amdgcn_rcpf(ssum);
#pragma unroll
      for (int k = 0; k < 16; k++) {
        const u32 code = stairS[63 - (int)(T[k] & 63u)];
        const int ia = 127 - (int)(la[(code >> 4) & 15] & 127u), ib = 127 - (int)(lb[code & 15] & 127u);
        eidx[k] = ia * 128 + ib;
        gate[k] = e[k] * rs;
      }
#pragma unroll
      for (int b = 0; b < 8; b++) {
        int c = 0;
#pragma unroll
        for (int k = 0; k < 16; k++) c += ((eidx[k] >> 11) == b) ? 1 : 0;
        cntS[(token * 8 + head) * 8 + b] = c;
      }
    }
    __syncthreads();
    if (tid < 128) {
      const int token = tid >> 3, head = tid & 7;
      int base[8];
      {
        int run = 0;
#pragma unroll
        for (int b = 0; b < 8; b++) {
          int mine = 0, tot = 0;
#pragma unroll
          for (int hh = 0; hh < 8; hh++) {
            const int c = cntS[(token * 8 + hh) * 8 + b];
            mine += (hh < head) ? c : 0;
            tot += c;
          }
          base[b] = run + mine;
          run += tot;
        }
      }
      float2* ro = ROUTE + (size_t)(tok0 + token) * 128;
#pragma unroll
      for (int k = 0; k < 16; k++) {
        const int bk = eidx[k] >> 11;
        int pos = 0;
#pragma unroll
        for (int b = 0; b < 8; b++) pos += (bk == b) ? base[b] : 0;
#pragma unroll
        for (int k2 = 0; k2 < 16; k2++)
          if (k2 < k) pos += ((eidx[k2] >> 11) == bk) ? 1 : 0;
        ro[pos] = make_float2(gate[k], __int_as_float(eidx[k]));
      }
    }
  }
}
#undef INS16

__device__ __forceinline__ void unpack8(uint4 w, float* f) {
  f[0] = lo16(w.x); f[1] = hi16(w.x); f[2] = lo16(w.y); f[3] = hi16(w.y);
  f[4] = lo16(w.z); f[5] = hi16(w.z); f[6] = lo16(w.w); f[7] = hi16(w.w);
}

__device__ __forceinline__ void unpack_fp8x16(uint4 w, float* f) {
  typedef float f2_ __attribute__((ext_vector_type(2)));
  f2_ t;
  t = __builtin_amdgcn_cvt_pk_f32_fp8((int)w.x, false); f[0] = t.x; f[1] = t.y;
  t = __builtin_amdgcn_cvt_pk_f32_fp8((int)w.x, true); f[2] = t.x; f[3] = t.y;
  t = __builtin_amdgcn_cvt_pk_f32_fp8((int)w.y, false); f[4] = t.x; f[5] = t.y;
  t = __builtin_amdgcn_cvt_pk_f32_fp8((int)w.y, true); f[6] = t.x; f[7] = t.y;
  t = __builtin_amdgcn_cvt_pk_f32_fp8((int)w.z, false); f[8] = t.x; f[9] = t.y;
  t = __builtin_amdgcn_cvt_pk_f32_fp8((int)w.z, true); f[10] = t.x; f[11] = t.y;
  t = __builtin_amdgcn_cvt_pk_f32_fp8((int)w.w, false); f[12] = t.x; f[13] = t.y;
  t = __builtin_amdgcn_cvt_pk_f32_fp8((int)w.w, true); f[14] = t.x; f[15] = t.y;
}

__device__ __forceinline__ void phase_peer(const Params& p) {
  char* ws = p.ws;
  const unsigned char* PU = (const unsigned char*)(ws + OFF_PU);
  const unsigned char* PV = (const unsigned char*)(ws + OFF_PV);
  const u16* Hf = (const u16*)(ws + OFF_H);
  const float2* ROUTE = (const float2*)(ws + OFF_ROUTE);
  const int lane = threadIdx.x & 63;
  const int gw = blockIdx.x * 4 + (threadIdx.x >> 6), nw = gridDim.x * 4;
#pragma unroll 1
  for (int tk = gw; tk < NT; tk += nw) {
    float xf[16], o[16];
    unpack8(*(const uint4*)(Hf + (size_t)tk * HLD + lane * 16), xf);
    unpack8(*(const uint4*)(Hf + (size_t)tk * HLD + lane * 16 + 8), xf + 8);
#pragma unroll
    for (int j = 0; j < 16; j++) o[j] = 0.f;
    const float2* rt = ROUTE + (size_t)tk * 128;
    float2 rA[4], rB[4];
    uint4 uA[4], vA[4], uB[4], vB[4];
#define PLOAD(R, U, V, E)                                                        \
  _Pragma("unroll") for (int q = 0; q < 4; q++) {                                \
    R[q] = rt[(E) + q];                                                          \
    const size_t off = (size_t)__float_as_int(R[q].y) * 2048 + lane * 16;        \
    U[q] = *(const uint4*)(PU + off);                                            \
    V[q] = *(const uint4*)(PU + off + 1024);                                     \
  }
#define PCOMP(R, U, V)                                                           \
  _Pragma("unroll") for (int q = 0; q < 4; q++) {                                \
    float uf[16];                                                                \
    unpack_fp8x16(U[q], uf);                                                     \
    float d = 0.f;                                                               \
    _Pragma("unroll") for (int j = 0; j < 16; j++) d += uf[j] * xf[j];           \
    d = wave_sum(d) * (1.f / 64.f);                                              \
    const float act = 0.5f * d * (1.f + erff(d * 0.70710678118654752f));         \
    const float cf = R[q].x * act * (1.f / 16.f);                                \
    float vf[16];                                                                \
    unpack_fp8x16(V[q], vf);                                                     \
    _Pragma("unroll") for (int j = 0; j < 16; j++) o[j] += cf * vf[j];           \
  }
    PLOAD(rA, uA, vA, 0)
#pragma unroll 1
    for (int e = 0; e < 128; e += 8) {
      PLOAD(rB, uB, vB, e + 4)
      PCOMP(rA, uA, vA)
      if (e + 8 < 128) { PLOAD(rA, uA, vA, e + 8) }
      PCOMP(rB, uB, vB)
    }
#undef PLOAD
#undef PCOMP
    float* yr = p.out + (size_t)tk * 1024 + lane * 16;
    float4 x0 = *(const float4*)(yr), x1 = *(const float4*)(yr + 4), x2 = *(const float4*)(yr + 8), x3 = *(const float4*)(yr + 12);
    o[0] += x0.x; o[1] += x0.y; o[2] += x0.z; o[3] += x0.w; o[4] += x1.x; o[5] += x1.y; o[6] += x1.z; o[7] += x1.w;
    o[8] += x2.x; o[9] += x2.y; o[10] += x2.z; o[11] += x2.w; o[12] += x3.x; o[13] += x3.y; o[14] += x3.z; o[15] += x3.w;
    float ss = 0.f;
#pragma unroll
    for (int j = 0; j < 16; j++) ss += o[j] * o[j];
    ss = wave_sum(ss);
    const float rr = rsqrtf(ss * (1.f / 1024.f) + 1e-6f);
    const float* gf = p.g_final + lane * 16;
    float4 g0 = *(const float4*)(gf), g1 = *(const float4*)(gf + 4), g2 = *(const float4*)(gf + 8), g3 = *(const float4*)(gf + 12);
    *(float4*)(yr) = make_float4(o[0] * rr * g0.x, o[1] * rr * g0.y, o[2] * rr * g0.z, o[3] * rr * g0.w);
    *(float4*)(yr + 4) = make_float4(o[4] * rr * g1.x, o[5] * rr * g1.y, o[6] * rr * g1.z, o[7] * rr * g1.w);
    *(float4*)(yr + 8) = make_float4(o[8] * rr * g2.x, o[9] * rr * g2.y, o[10] * rr * g2.z, o[11] * rr * g2.w);
    *(float4*)(yr + 12) = make_float4(o[12] * rr * g3.x, o[13] * rr * g3.y, o[14] * rr * g3.z, o[15] * rr * g3.w);
  }
}

#define XB_TMO      128
#define XB_XCNT(j)  (256  + 64 * (j))
#define XB_XSUB(j)  (1280 + 64 * (j))
#define XB_XGEN(j)  (2304 + 64 * (j))
#define XB_TOP      3328
#define XB_TOPGEN   3392
#define XCD_BAR_WORDS 3456
#define XB_SPIN_CAP (1u << 18)
#define LAS __attribute__((address_space(3)))
__device__ __forceinline__ unsigned xb_ld(unsigned* p) { return __hip_atomic_load(p, __ATOMIC_RELAXED, __HIP_MEMORY_SCOPE_AGENT); }
__device__ __forceinline__ unsigned xb_add(unsigned* p, unsigned v) { return __hip_atomic_fetch_add(p, v, __ATOMIC_RELAXED, __HIP_MEMORY_SCOPE_AGENT); }
__device__ __forceinline__ unsigned xb_xcc_id() { return (unsigned)__builtin_amdgcn_s_getreg((3 << 11) | 20) & 0xFu; }
#define XB_SPIN(cond, bar) do { unsigned _sp = 0; while (cond) { __builtin_amdgcn_s_sleep(1); \
    if ((++_sp & 255u) == 0u) { if (xb_ld(&(bar)[XB_TMO])) break; if (_sp > XB_SPIN_CAP) { atomicAdd(&(bar)[XB_TMO], 1u); break; } } } } while (0)
struct XcdBarrier { unsigned* bar; unsigned x; volatile LAS unsigned* st; };
__device__ __forceinline__ XcdBarrier xcd_barrier_post(unsigned* bar, volatile LAS unsigned* st) {
  XcdBarrier b; b.bar = bar; b.x = xb_xcc_id(); b.st = st;
  if (threadIdx.x == 0) (void)xb_add(&bar[XB_XCNT(b.x)], 1u);
  return b;
}
__device__ __forceinline__ void xcd_barrier_complete(unsigned* bar, unsigned x, unsigned& nloc, unsigned& nx) {
  const unsigned G = gridDim.x * gridDim.y * gridDim.z;
  unsigned sum, cnt, mine, sp = 0u;
  for (;;) {
    sum = 0u; cnt = 0u; mine = 0u;
#pragma unroll
    for (unsigned j = 0; j < 16; ++j) { const unsigned c = xb_ld(&bar[XB_XCNT(j)]); sum += c; cnt += (c > 0u) ? 1u : 0u; mine = (j == x) ? c : mine; }
    if (sum == G) break;
    __builtin_amdgcn_s_sleep(1);
    if ((++sp & 255u) == 0u) { if (xb_ld(&bar[XB_TMO])) break; if (sp > XB_SPIN_CAP) { atomicAdd(&bar[XB_TMO], 1u); break; } }
  }
  nloc = mine > 0u ? mine : 1u; nx = cnt > 0u ? cnt : 1u;
}
__device__ __forceinline__ void xcd_barrier(unsigned* bbar, unsigned bx, volatile LAS unsigned* bst) {
  asm volatile("s_waitcnt vmcnt(0)" ::: "memory");
  __syncthreads();
  if (threadIdx.x == 0) {
    unsigned* bar = bbar;
    __builtin_amdgcn_s_waitcnt(0);
    unsigned nloc = bst[0], nx = bst[1];
    if (nloc == 0u) { xcd_barrier_complete(bar, bx, nloc, nx); bst[0] = nloc; bst[1] = nx; }
    const unsigned old = xb_add(&bar[XB_XSUB(bx)], 1u);
    const unsigned gen = old / nloc;
    if (old + 1u == (gen + 1u) * nloc) {
      __builtin_amdgcn_fence(__ATOMIC_RELEASE, "agent");
      asm volatile("s_waitcnt vmcnt(0)" ::: "memory");
      const unsigned og = xb_add(&bar[XB_TOP], 1u);
      const unsigned tg = og / nx;
      if (og + 1u == (tg + 1u) * nx) xb_add(&bar[XB_TOPGEN], 1u);
      else XB_SPIN(xb_ld(&bar[XB_TOPGEN]) == tg, bar);
      __builtin_amdgcn_fence(__ATOMIC_ACQUIRE, "agent");
      xb_add(&bar[XB_XGEN(bx)], 1u);
      asm volatile("s_waitcnt vmcnt(0)" ::: "memory");
    } else {
      XB_SPIN(xb_ld(&bar[XB_XGEN(bx)]) == gen, bar);
      __builtin_amdgcn_fence(__ATOMIC_ACQUIRE, "agent");
      asm volatile("s_waitcnt vmcnt(0)" ::: "memory");
    }
  }
  __syncthreads();
}

__global__ void __launch_bounds__(256, 2) fwd_kernel(Params pk) {
  __shared__ __attribute__((aligned(16))) char smem[SMEM_BYTES];
  __shared__ int s_item;
  __shared__ uint4 xb_words;
  if (threadIdx.x == 0) xb_words = make_uint4(0u, 0u, 0u, 0u);
  __syncthreads();
  unsigned* const xb_bar = (unsigned*)(pk.ws + OFF_BAR);
  volatile LAS unsigned* const xb_st = (volatile LAS unsigned*)&xb_words;
  const unsigned xb_x = xb_xcc_id();
  if (threadIdx.x == 0) (void)xb_add(&xb_bar[XB_XCNT(xb_x)], 1u);
#ifdef ONLY_PHASE
#define RUN(PH, ...) if (PH == ONLY_PHASE) { const Params& p = pk; char* ws = p.ws; (void)ws; __VA_ARGS__; }
#else
typedef const Params __attribute__((address_space(4))) * KParamsPtr;
#if defined(__HIP_DEVICE_COMPILE__)
#define LOAD_PARAMS                                                                   \
  KParamsPtr kp_ = (KParamsPtr)__builtin_amdgcn_kernarg_segment_ptr();                \
  asm volatile("" : "+s"(kp_));                                                       \
  const Params p = *kp_;
#else
#define LOAD_PARAMS const Params p = pk;
#endif
#define RUN(PH, ...)                                   \
  if (pk.ph0 <= PH && PH < pk.ph1) {                   \
    {                                                  \
      LOAD_PARAMS                                      \
      char* ws = p.ws;                                 \
      (void)ws;                                        \
      __VA_ARGS__;                                     \
    }                                                  \
    if (PH + 1 < pk.ph1) xcd_barrier(xb_bar, xb_x, xb_st); \
  }
#endif
  RUN(0, phase_prep(p, smem))
  RUN(1, phase_gemm_in(p, smem); prep_jobs(p, smem, 1440, 1952))
  RUN(2, phase_conv(p))
  RUN(3, phase_mixers(p, smem, &s_item))
  RUN(4, mlstm_scan(p))
  RUN(5, phase_mlstm_out(p, smem))
  RUN(6, phase_mixed(p, smem))
  RUN(7, phase_gemm_generic(p, smem, (const u16*)(ws + OFF_H), (const u16*)(ws + OFF_WT_OUT), 8, 0, nullptr, 0); prep_jobs(p, smem, 2464, 3488))
  RUN(8, phase_norm(p, p.g_cross))
  RUN(9, phase_gemm_generic(p, smem, (const u16*)(ws + OFF_H), (const u16*)(ws + OFF_WT_CQ), 8, 2, (u16*)(ws + OFF_QC), HLD); prep_jobs(p, smem, 4512, 5536); prep_memk(p))
  RUN(10, phase_cross(p, smem))
  RUN(11, phase_gemm_generic(p, smem, (const u16*)(ws + OFF_QC), (const u16*)(ws + OFF_WT_CO), 8, 1, nullptr, 0))
  RUN(12, phase_norm(p, p.g_ffn))
  RUN(13, phase_gemm_generic(p, smem, (const u16*)(ws + OFF_H), (const u16*)(ws + OFF_WT_PQ), 16, 2, (u16*)(ws + OFF_PQ), PQLD))
  RUN(14, phase_route(p, smem))
  RUN(15, phase_peer(p))
  if (pk.ph0 < 0) cg::this_grid().sync();
}

extern "C" void kernel_launch(void* const* d_in, const int* in_sizes, int n_in, void* d_out, int out_size, void* d_ws,
                              size_t ws_size, hipStream_t stream) {
  static int grid_blocks = 0;
  static int cus = 0;
  if (!cus) {
    int dev = 0;
    (void)hipGetDevice(&dev);
    (void)hipDeviceGetAttribute(&cus, hipDeviceAttributeMultiprocessorCount, dev);
    if (cus <= 0) cus = 256;
  }
  Params p;
  memset(&p, 0, sizeof(p));
  const float** f = (const float**)&p;
  for (int i = 0; i < 33; i++) f[i] = (const float*)d_in[i];
  p.out = (float*)d_out;
  p.ws = (char*)d_ws;
#if COOP
  p.ph0 = 0; p.ph1 = NPHASE;
  void* args[] = {&p};
  (void)hipMemsetAsync((char*)d_ws + OFF_BAR, 0, XCD_BAR_WORDS * 4, stream);
  if (!grid_blocks) {
    hipError_t e = hipLaunchCooperativeKernel((void*)fwd_kernel, dim3(2 * cus), dim3(256), args, 0, stream);
    if (e == hipSuccess) { grid_blocks = 2 * cus; return; }
    (void)hipGetLastError();
    grid_blocks = cus;
  }
  hipError_t e = hipLaunchCooperativeKernel((void*)fwd_kernel, dim3(grid_blocks), dim3(256), args, 0, stream);
  if (e != hipSuccess) fprintf(stderr, "cooperative launch failed: %s (grid %d)\n", hipGetErrorString(e), grid_blocks);
#else
  for (int ph = 0; ph < NPHASE; ph++) {
    p.ph0 = ph; p.ph1 = ph + 1;
    hipLaunchKernelGGL(fwd_kernel, dim3(2 * cus), dim3(256), 0, stream, p);
  }
#endif
}
```

```cpp
#include <hip/hip_runtime.h>
#include <hip/hip_cooperative_groups.h>
#include <cstdio>
#include <cstring>
namespace cg = cooperative_groups;

#ifndef COOP
#define COOP 1
#endif

typedef unsigned short u16;
typedef unsigned int u32;
typedef __attribute__((ext_vector_type(8))) short bf16x8;
typedef __attribute__((ext_vector_type(4))) float f32x4;
#define MFMA(a, b, c) __builtin_amdgcn_mfma_f32_16x16x32_bf16(a, b, c, 0, 0, 0)

constexpr int NT = 16896;
constexpr int NP = 16384;
constexpr int ZLD = 3712;
constexpr int NPHASE = 16;
constexpr int HLD = 1152;
constexpr int WLD5 = 640;
constexpr int PQLD = 2176;
constexpr int VLD = 17024;

constexpr size_t OFF_WT_IN = 0;
constexpr size_t OFF_WT_AUP = OFF_WT_IN + 5760ull * HLD * 2;
constexpr size_t OFF_WT_BUP = OFF_WT_AUP + 1024ull * WLD5 * 2;
constexpr size_t OFF_WT_OUT = OFF_WT_BUP + 1024ull * WLD5 * 2;
constexpr size_t OFF_WT_MKV = OFF_WT_OUT + 1024ull * HLD * 2;
constexpr size_t OFF_WT_CQ = OFF_WT_MKV + 2048ull * HLD * 2;
constexpr size_t OFF_WT_CO = OFF_WT_CQ + 1024ull * HLD * 2;
constexpr size_t OFF_WT_PQ = OFF_WT_CO + 1024ull * HLD * 2;
constexpr size_t OFF_SUBK = OFF_WT_PQ + 2048ull * HLD * 2;
constexpr size_t OFF_CTR = OFF_SUBK + 262144ull * 2;
constexpr size_t OFF_P = OFF_CTR + 4096;
constexpr size_t OFF_PU = OFF_P;
constexpr size_t OFF_PV = OFF_P + 16384ull * 1024;
constexpr size_t OFF_ROUTE = OFF_P + 2ull * 16384 * 1024;
constexpr size_t OFF_KC = OFF_P;
constexpr size_t OFF_VCT = OFF_KC + 16ull * 512 * 512 * 2;
constexpr size_t OFF_VAT = OFF_VCT + 16ull * 512 * 512 * 2;
constexpr size_t OFF_VBT = OFF_VAT + 512ull * VLD * 2;
constexpr size_t OFF_MN = OFF_VBT + 512ull * VLD * 2;
constexpr size_t OFF_H = OFF_P + 2ull * 16384 * 1024 * 2;
constexpr size_t OFF_Z = OFF_H + (size_t)NT * HLD * 2;
constexpr size_t OFF_QC = OFF_Z;
constexpr size_t OFF_PQ = OFF_Z + (size_t)NT * HLD * 2;
constexpr size_t OFF_MK = OFF_Z + (size_t)NT * ZLD * 2;
constexpr size_t OFF_MVT = OFF_MK + 6144ull * HLD * 2;
constexpr size_t OFF_DELTA = OFF_MVT + 6144ull * 1024 * 2;
constexpr size_t OFF_NBUF = OFF_DELTA + 1024ull * 16384 * 2;
constexpr size_t OFF_SCAL = OFF_NBUF + 1024ull * 128 * 4;
constexpr size_t OFF_BAR = OFF_SCAL + 1024ull * 4 * 4;
constexpr size_t WS_END = OFF_BAR + 16384;
static_assert(OFF_MN + 2048ull * HLD * 2 <= OFF_H, "early scratch overflows peer region");
static_assert(OFF_ROUTE + (size_t)NT * 128 * 8 <= OFF_H, "route overflows peer region");
static_assert(OFF_PQ + (size_t)NT * PQLD * 2 <= OFF_MK, "pq overflows z region");
static_assert(WS_END <= 336ull * 1000 * 1000, "workspace budget");

constexpr size_t O_Y = 0;
constexpr size_t O_PAK = (size_t)NT * 1024;
constexpr size_t O_PAV = O_PAK + 2097152;
constexpr size_t O_PBCONV = O_PAV + 2097152;
constexpr size_t O_PBC = O_PBCONV + 24576;
constexpr size_t O_PBN = O_PBC + 524288;
constexpr size_t O_PBM = O_PBN + 4096;
constexpr size_t O_PMK = O_PBM + 32;
constexpr size_t O_PMV = O_PMK + 2097152;
constexpr size_t O_SAK = O_PMV + 2097152;
constexpr size_t O_SAV = O_SAK + 262144;
constexpr size_t O_SBCONV = O_SAV + 262144;
constexpr size_t O_SBC = O_SBCONV + 49152;
constexpr size_t O_SBN = O_SBC + 1048576;
constexpr size_t O_SBM = O_SBN + 8192;

constexpr int SMEM_BYTES = 79872;

struct Params {
  const float *x_prompt, *x_sample, *mem_prompt, *cache_a_k, *cache_a_v, *state_b_conv, *state_b_C, *state_b_n,
      *state_b_m, *cache_mem_k, *cache_mem_v;
  const float *g_mix, *w_in, *conv_w, *conv_b, *b_if, *g_head, *rel_bias, *w_a_up, *w_b_up, *w_out, *g_mem, *w_mk,
      *w_mv, *g_cross, *w_cq, *w_co, *g_ffn, *w_pq, *sub_keys, *peer_u, *peer_v, *g_final;
  float* out;
  char* ws;
  int ph0, ph1;
};

__device__ __forceinline__ float bf2f(u16 h) { return __uint_as_float(((u32)h) << 16); }
__device__ __forceinline__ u32 pack2(float lo, float hi) {
  u32 r;
  asm("v_cvt_pk_bf16_f32 %0,%1,%2" : "=v"(r) : "v"(lo), "v"(hi));
  return r;
}
__device__ __forceinline__ u16 f2bf(float f) { return (u16)(pack2(f, 0.f) & 0xffffu); }
__device__ __forceinline__ float lo16(u32 w) { return __uint_as_float(w << 16); }
__device__ __forceinline__ float hi16(u32 w) { return __uint_as_float(w & 0xffff0000u); }

template <int CTRL>
__device__ __forceinline__ float dppf(float v) {
  return __int_as_float(__builtin_amdgcn_update_dpp(0, __float_as_int(v), CTRL, 0xF, 0xF, true));
}
template <int CTRL>
__device__ __forceinline__ u32 dppu(u32 v) {
  return (u32)__builtin_amdgcn_update_dpp(0, (int)v, CTRL, 0xF, 0xF, true);
}
__device__ __forceinline__ float row16_sum(float v) {
  v += dppf<0xB1>(v); v += dppf<0x4E>(v); v += dppf<0x141>(v); v += dppf<0x140>(v);
  return v;
}
__device__ __forceinline__ float row16_max(float v) {
  v = fmaxf(v, dppf<0xB1>(v)); v = fmaxf(v, dppf<0x4E>(v)); v = fmaxf(v, dppf<0x141>(v)); v = fmaxf(v, dppf<0x140>(v));
  return v;
}
__device__ __forceinline__ u32 umax2(u32 a, u32 b) { return a > b ? a : b; }
__device__ __forceinline__ u32 row16_umax(u32 v) {
  v = umax2(v, dppu<0xB1>(v)); v = umax2(v, dppu<0x4E>(v)); v = umax2(v, dppu<0x141>(v)); v = umax2(v, dppu<0x140>(v));
  return v;
}
__device__ __forceinline__ float wave_sum(float v) {
  v = row16_sum(v);
  v += __shfl_xor(v, 16);
  v += __shfl_xor(v, 32);
  return v;
}
__device__ __forceinline__ u32 ordk(float f) {
  u32 u = __float_as_uint(f);
  return u ^ ((u32)((int)u >> 31) | 0x80000000u);
}
__device__ __forceinline__ float unordk(u32 k) { return __uint_as_float(k ^ ((~(u32)((int)k >> 31)) | 0x80000000u)); }
__device__ __forceinline__ float sigmoidf_(float x) { return __builtin_amdgcn_rcpf(1.f + __expf(-x)); }
__device__ __forceinline__ uint4 zero4() { return make_uint4(0, 0, 0, 0); }

__device__ __forceinline__ void transpose_tile(const float* __restrict__ src, int src_ld, int k0, int c0, int col_lim,
                               u16* __restrict__ dst, int dst_ld, int dst_r0, float* tile) {
  const int tid = threadIdx.x, c = tid & 63, r4 = tid >> 6;
  {
    float tv[16];
    const int cc0 = c < col_lim ? c : 0;
#pragma unroll
    for (int i = 0; i < 16; i++) tv[i] = src[(size_t)(k0 + r4 + 4 * i) * src_ld + c0 + cc0];
#pragma unroll
    for (int i = 0; i < 16; i++) tile[(r4 + 4 * i) * 65 + c] = (c < col_lim) ? tv[i] : 0.f;
  }
  __syncthreads();
#pragma unroll 4
  for (int i = 0; i < 16; i++) {
    int cc = r4 + 4 * i;
    dst[(size_t)(dst_r0 + cc) * dst_ld + k0 + c] = f2bf(tile[c * 65 + cc]);
  }
  __syncthreads();
}

__device__ __forceinline__ void rms_row_to_bf16(const float* __restrict__ src, const float* __restrict__ g,
                                                u16* __restrict__ dst, int lane) {
  float4 v[4];
  float ss = 0.f;
#pragma unroll
  for (int i = 0; i < 4; i++) {
    v[i] = ((const float4*)src)[lane + 64 * i];
    ss += v[i].x * v[i].x + v[i].y * v[i].y + v[i].z * v[i].z + v[i].w * v[i].w;
  }
  ss = wave_sum(ss);
  float r = rsqrtf(ss * (1.f / 1024.f) + 1e-6f);
#pragma unroll
  for (int i = 0; i < 4; i++) {
    float4 gg = ((const float4*)g)[lane + 64 * i];
    uint2 o;
    o.x = pack2(v[i].x * r * gg.x, v[i].y * r * gg.y);
    o.y = pack2(v[i].z * r * gg.z, v[i].w * r * gg.w);
    ((uint2*)dst)[lane + 64 * i] = o;
  }
}

__device__ __forceinline__ void cvt_bf16(const float* __restrict__ src, u16* __restrict__ dst, size_t n) {
  size_t n8 = n >> 3;
  for (size_t i = (size_t)blockIdx.x * 256 + threadIdx.x; i < n8; i += (size_t)gridDim.x * 256) {
    float4 a = ((const float4*)src)[2 * i], b = ((const float4*)src)[2 * i + 1];
    uint4 o;
    o.x = pack2(a.x, a.y); o.y = pack2(a.z, a.w); o.z = pack2(b.x, b.y); o.w = pack2(b.z, b.w);
    ((uint4*)dst)[i] = o;
  }
}

__device__ __forceinline__ void cvt_fp8(const float* __restrict__ src, unsigned char* __restrict__ dst, size_t n, float scale) {
  size_t n16 = n >> 4;
  for (size_t i = (size_t)blockIdx.x * 256 + threadIdx.x; i < n16; i += (size_t)gridDim.x * 256) {
    const float4* sp = (const float4*)src + 4 * i;
    float4 a = sp[0], b = sp[1], c = sp[2], d = sp[3];
    int w0 = 0, w1 = 0, w2 = 0, w3 = 0;
    w0 = __builtin_amdgcn_cvt_pk_fp8_f32(a.x * scale, a.y * scale, w0, false);
    w0 = __builtin_amdgcn_cvt_pk_fp8_f32(a.z * scale, a.w * scale, w0, true);
    w1 = __builtin_amdgcn_cvt_pk_fp8_f32(b.x * scale, b.y * scale, w1, false);
    w1 = __builtin_amdgcn_cvt_pk_fp8_f32(b.z * scale, b.w * scale, w1, true);
    w2 = __builtin_amdgcn_cvt_pk_fp8_f32(c.x * scale, c.y * scale, w2, false);
    w2 = __builtin_amdgcn_cvt_pk_fp8_f32(c.z * scale, c.w * scale, w2, true);
    w3 = __builtin_amdgcn_cvt_pk_fp8_f32(d.x * scale, d.y * scale, w3, false);
    w3 = __builtin_amdgcn_cvt_pk_fp8_f32(d.z * scale, d.w * scale, w3, true);
    *(uint4*)(dst + (i >> 6) * 2048 + (i & 63) * 16) = make_uint4((u32)w0, (u32)w1, (u32)w2, (u32)w3);
  }
}

__device__ __forceinline__ void prep_jobs(const Params& p, char* smem, int jlo, int jhi) {
  float* tile = (float*)smem;
  char* ws = p.ws;
  for (int j = jlo + blockIdx.x; j < jhi; j += gridDim.x) {
    if (j < 928) { int kt = j & 15, nt = j >> 4;
      transpose_tile(p.w_in, 5640, kt * 64, nt * 64, 3592 - nt * 64, (u16*)(ws + OFF_WT_IN), HLD, nt * 64, tile);
    } else if (j < 1440) { int q = j - 928; int kt = q & 15, nt = q >> 4;
      transpose_tile(p.w_in, 5640, kt * 64, 3592 + nt * 64, 64, (u16*)(ws + OFF_WT_IN), HLD, 3712 + nt * 64, tile);
    } else if (j < 1568) { int q = j - 1440; int kt = q & 7, nt = q >> 3;
      transpose_tile(p.w_a_up, 1024, kt * 64, nt * 64, 64, (u16*)(ws + OFF_WT_AUP), WLD5, nt * 64, tile);
    } else if (j < 1696) { int q = j - 1568; int kt = q & 7, nt = q >> 3;
      transpose_tile(p.w_b_up, 1024, kt * 64, nt * 64, 64, (u16*)(ws + OFF_WT_BUP), WLD5, nt * 64, tile);
    } else if (j < 1952) { int q = j - 1696; int kt = q & 15, nt = q >> 4;
      transpose_tile(p.w_out, 1024, kt * 64, nt * 64, 64, (u16*)(ws + OFF_WT_OUT), HLD, nt * 64, tile);
    } else if (j < 2208) { int q = j - 1952; int kt = q & 15, nt = q >> 4;
      transpose_tile(p.w_mk, 1024, kt * 64, nt * 64, 64, (u16*)(ws + OFF_WT_MKV), HLD, nt * 64, tile);
    } else if (j < 2464) { int q = j - 2208; int kt = q & 15, nt = q >> 4;
      transpose_tile(p.w_mv, 1024, kt * 64, nt * 64, 64, (u16*)(ws + OFF_WT_MKV), HLD, 1024 + nt * 64, tile);
    } else if (j < 2720) { int q = j - 2464; int kt = q & 15, nt = q >> 4;
      transpose_tile(p.w_cq, 1024, kt * 64, nt * 64, 64, (u16*)(ws + OFF_WT_CQ), HLD, nt * 64, tile);
    } else if (j < 2976) { int q = j - 2720; int kt = q & 15, nt = q >> 4;
      transpose_tile(p.w_co, 1024, kt * 64, nt * 64, 64, (u16*)(ws + OFF_WT_CO), HLD, nt * 64, tile);
    } else if (j < 3488) { int q = j - 2976; int kt = q & 15, nt = q >> 4;
      transpose_tile(p.w_pq, 2048, kt * 64, nt * 64, 64, (u16*)(ws + OFF_WT_PQ), HLD, nt * 64, tile);
    } else if (j < 4512) { int q = j - 3488; int kt = q & 7, nt = (q >> 3) & 7, sb = q >> 6;
      transpose_tile(p.cache_a_v + (size_t)sb * 512 * 512, 512, kt * 64, nt * 64, 64,
                     (u16*)(ws + OFF_VCT) + (size_t)sb * 512 * 512, 512, nt * 64, tile);
    } else { int q = j - 4512; int kt = q & 3, nt = (q >> 2) & 15, sb = q >> 6;
      transpose_tile(p.cache_mem_v + (size_t)sb * 256 * 1024, 1024, kt * 64, nt * 64, 64,
                     (u16*)(ws + OFF_MVT) + (size_t)(8 + sb) * 1024 * 256, 256, nt * 64, tile);
    }
  }
}

__device__ __forceinline__ void prep_memk(const Params& p) {
  char* ws = p.ws;
  {
    u16* MKs = (u16*)(ws + OFF_MK) + 2048ull * HLD;
    for (size_t i = (size_t)blockIdx.x * 256 + threadIdx.x; i < 4096ull * 128; i += (size_t)gridDim.x * 256) {
      const size_t r = i >> 7, c8 = (i & 127) * 8;
      const float4 a = *(const float4*)(p.cache_mem_k + r * 1024 + c8), b = *(const float4*)(p.cache_mem_k + r * 1024 + c8 + 4);
      uint4 o;
      o.x = pack2(a.x, a.y); o.y = pack2(a.z, a.w); o.z = pack2(b.x, b.y); o.w = pack2(b.z, b.w);
      *(uint4*)(MKs + r * HLD + c8) = o;
    }
  }
}

__device__ __forceinline__ void phase_prep(const Params& p, char* smem) {
  char* ws = p.ws;
  if (blockIdx.x == 0 && threadIdx.x < 16) ((int*)(ws + OFF_CTR))[threadIdx.x] = 0;
  prep_jobs(p, smem, 0, 1440);
  prep_jobs(p, smem, 1952, 2464);
  prep_jobs(p, smem, 3488, 4512);
  const int lane = threadIdx.x & 63, gw = blockIdx.x * 4 + (threadIdx.x >> 6), nw = gridDim.x * 4;
  for (int r = gw; r < NT + 2048; r += nw) {
    if (r < NP) rms_row_to_bf16(p.x_prompt + (size_t)r * 1024, p.g_mix, (u16*)(ws + OFF_H) + (size_t)r * HLD, lane);
    else if (r < NT) rms_row_to_bf16(p.x_sample + (size_t)(r - NP) * 1024, p.g_mix, (u16*)(ws + OFF_H) + (size_t)r * HLD, lane);
    else rms_row_to_bf16(p.mem_prompt + (size_t)(r - NT) * 1024, p.g_mem, (u16*)(ws + OFF_MN) + (size_t)(r - NT) * HLD, lane);
  }
  cvt_bf16(p.cache_a_k, (u16*)(ws + OFF_KC), 16ull * 512 * 512);
  cvt_bf16(p.sub_keys, (u16*)(ws + OFF_SUBK), 262144);
}

__device__ __forceinline__ void lds_barrier() {
  asm volatile("s_waitcnt lgkmcnt(0)" ::: "memory");
  __builtin_amdgcn_s_barrier();
  asm volatile("" ::: "memory");
}

__device__ __forceinline__ void gemm_tile(const u16* __restrict__ A, int lda, const u16* __restrict__ Bt, int ldb, int K,
                                          int m0, int n0, u16* smem, f32x4 (&acc)[4][4]) {
  int tid = threadIdx.x;
  asm volatile("" : "+v"(tid));
  const int lane = tid & 63, wave = tid >> 6;
  const int wr = wave >> 1, wc = wave & 1, col = lane & 15, grp = lane >> 4;
  const int c4 = lane & 3, r1 = (lane >> 2) & 1, half = (lane >> 3) & 1, r2 = lane >> 4;
  const int lrow = wave * 8 + r2 * 2 + r1;
  char* As = (char*)smem;
  char* Bs = As + 2 * 16384;
  int wofs;
  {
    const int ob = (lrow & 15) * 64 + c4 * 16;
    wofs = ((lrow >> 4) * 2 + half) * 1024 + (ob ^ (((ob >> 9) & 1) << 5));
  }
  int rofs;
  {
    const int ob = col * 64 + grp * 16;
    rofs = ob ^ (((ob >> 9) & 1) << 5);
  }
  const int aofs = rofs + wr * 8192, bofs = rofs + wc * 8192;
  const u16* Ag = A + (size_t)(m0 + lrow) * lda + half * 32 + c4 * 8;
  const u16* Bg = Bt + (size_t)(n0 + lrow) * ldb + half * 32 + c4 * 8;
  uint4 r0a0, r0a1, r0a2, r0a3, r0b0, r0b1, r0b2, r0b3;
  uint4 r1a0, r1a1, r1a2, r1a3, r1b0, r1b1, r1b2, r1b3;
#define G_LOAD(S, KO)                                                                               \
  S##a0 = *(const uint4*)(Ag + (KO)); S##a1 = *(const uint4*)(Ag + (size_t)32 * lda + (KO));         \
  S##a2 = *(const uint4*)(Ag + (size_t)64 * lda + (KO)); S##a3 = *(const uint4*)(Ag + (size_t)96 * lda + (KO)); \
  S##b0 = *(const uint4*)(Bg + (KO)); S##b1 = *(const uint4*)(Bg + (size_t)32 * ldb + (KO));         \
  S##b2 = *(const uint4*)(Bg + (size_t)64 * ldb + (KO)); S##b3 = *(const uint4*)(Bg + (size_t)96 * ldb + (KO));
#define G_STORE(S, AP, BP)                                                                           \
  *(uint4*)((AP) + wofs) = S##a0; *(uint4*)((AP) + wofs + 4096) = S##a1;                             \
  *(uint4*)((AP) + wofs + 8192) = S##a2; *(uint4*)((AP) + wofs + 12288) = S##a3;                     \
  *(uint4*)((BP) + wofs) = S##b0; *(uint4*)((BP) + wofs + 4096) = S##b1;                             \
  *(uint4*)((BP) + wofs + 8192) = S##b2; *(uint4*)((BP) + wofs + 12288) = S##b3;
#define G_COMPUTE(CUR)                                                                               \
  {                                                                                                  \
    const char* Ac = As + (CUR) * 16384 + aofs;                                                      \
    const char* Bc = Bs + (CUR) * 16384 + bofs;                                                      \
    _Pragma("unroll") for (int ks = 0; ks < 2; ks++) {                                               \
      bf16x8 af0, af1, af2, af3, bq0, bq1, bq2, bq3;                                                 \
      af0 = *(const bf16x8*)(Ac + 0 * 2048 + ks * 1024);                                             \
      af1 = *(const bf16x8*)(Ac + 1 * 2048 + ks * 1024);                                             \
      af2 = *(const bf16x8*)(Ac + 2 * 2048 + ks * 1024);                                             \
      af3 = *(const bf16x8*)(Ac + 3 * 2048 + ks * 1024);                                             \
      bq0 = *(const bf16x8*)(Bc + 0 * 2048 + ks * 1024);                                             \
      bq1 = *(const bf16x8*)(Bc + 1 * 2048 + ks * 1024);                                             \
      bq2 = *(const bf16x8*)(Bc + 2 * 2048 + ks * 1024);                                             \
      bq3 = *(const bf16x8*)(Bc + 3 * 2048 + ks * 1024);                                             \
      acc[0][0] = MFMA(af0, bq0, acc[0][0]); acc[0][1] = MFMA(af0, bq1, acc[0][1]);                  \
      acc[0][2] = MFMA(af0, bq2, acc[0][2]); acc[0][3] = MFMA(af0, bq3, acc[0][3]);                  \
      acc[1][0] = MFMA(af1, bq0, acc[1][0]); acc[1][1] = MFMA(af1, bq1, acc[1][1]);                  \
      acc[1][2] = MFMA(af1, bq2, acc[1][2]); acc[1][3] = MFMA(af1, bq3, acc[1][3]);                  \
      acc[2][0] = MFMA(af2, bq0, acc[2][0]); acc[2][1] = MFMA(af2, bq1, acc[2][1]);                  \
      acc[2][2] = MFMA(af2, bq2, acc[2][2]); acc[2][3] = MFMA(af2, bq3, acc[2][3]);                  \
      acc[3][0] = MFMA(af3, bq0, acc[3][0]); acc[3][1] = MFMA(af3, bq1, acc[3][1]);                  \
      acc[3][2] = MFMA(af3, bq2, acc[3][2]); acc[3][3] = MFMA(af3, bq3, acc[3][3]);                  \
    }                                                                                                \
  }
#define G_STEP(KT, SS)                                                       \
  {                                                                          \
    __builtin_amdgcn_s_setprio(1);                                           \
    G_COMPUTE((KT) & 1)                                                      \
    __builtin_amdgcn_s_setprio(0);                                           \
    G_STORE(SS, As + (((KT) + 1) & 1) * 16384, Bs + (((KT) + 1) & 1) * 16384) \
    { const int kn = min((KT) + 3, nk - 1) * 64; G_LOAD(SS, kn) }            \
    lds_barrier();                                                           \
  }
  const int nk = K >> 6;
  G_LOAD(r0, 0)
  G_LOAD(r1, 64)
  G_STORE(r0, As, Bs)
  G_LOAD(r0, 128)
  lds_barrier();
#pragma unroll 1
  for (int kt = 0; kt < nk; kt += 2) {
    G_STEP(kt, r1)
    G_STEP(kt + 1, r0)
  }
  lds_barrier();
#undef G_LOAD
#undef G_STORE
#undef G_COMPUTE
#undef G_STEP
}

__device__ __forceinline__ bool sched_tile(int NTM, int NTN, int xcd, int j, int& mt, int& nt) {
  const int mb = (NTM * xcd) >> 3, me = (NTM * (xcd + 1)) >> 3, nm = me - mb;
  if (j >= nm * NTN) return false;
  const int nfull = nm >> 3, fullcnt = nfull * 8 * NTN;
  if (j < fullcnt) {
    const int mg = j / (8 * NTN), r = j - mg * 8 * NTN;
    nt = r >> 3; mt = mb + mg * 8 + (r & 7);
  } else {
    const int r = j - fullcnt, gsz = nm - nfull * 8;
    nt = r / gsz; mt = mb + nfull * 8 + (r - nt * gsz);
  }
  return true;
}

constexpr int TLD = 136;
template <bool TR>
__device__ __forceinline__ void epi_stage(f32x4 (&acc)[4][4], u16* T) {
  int lane = threadIdx.x & 63;
  asm volatile("" : "+v"(lane));
  const int wave = threadIdx.x >> 6, wr = wave >> 1, wc = wave & 1, col = lane & 15, grp = lane >> 4;
#pragma unroll
  for (int m = 0; m < 4; m++)
#pragma unroll
    for (int n = 0; n < 4; n++) {
      const int r = wr * 64 + m * 16 + grp * 4, c = wc * 64 + n * 16 + col;
      if (TR) {
        uint2 o; o.x = pack2(acc[m][n][0], acc[m][n][1]); o.y = pack2(acc[m][n][2], acc[m][n][3]);
        *(uint2*)(T + c * TLD + r) = o;
      } else {
#pragma unroll
        for (int j = 0; j < 4; j++) T[(r + j) * TLD + c] = f2bf(acc[m][n][j]);
      }
    }
  lds_barrier();
}
#define EPI_CHUNKS(T, ...)                                              \
  {                                                                     \
    int _t = threadIdx.x;                                               \
    asm volatile("" : "+v"(_t));                                        \
    _Pragma("unroll") for (int _i = 0; _i < 8; _i++) {                  \
      const int _ch = _t + 256 * _i;                                    \
      const int r = _ch >> 4, c8 = (_ch & 15) * 8;                      \
      const uint4 v = *(const uint4*)((T) + r * TLD + c8);              \
      __VA_ARGS__                                                       \
    }                                                                   \
    lds_barrier();                                                      \
  }

#define ACC_ZERO(acc)                                   \
  _Pragma("unroll") for (int m = 0; m < 4; m++)          \
  _Pragma("unroll") for (int n = 0; n < 4; n++) acc[m][n] = f32x4{0.f, 0.f, 0.f, 0.f};

#define EPI_LOOP(acc, m0, n0, ...)                                                               \
  {                                                                                              \
    int _lane = threadIdx.x & 63; const int _wave = threadIdx.x >> 6;                            \
    asm volatile("" : "+v"(_lane));                                                            \
    const int _wr = _wave >> 1, _wc = _wave & 1;                                                 \
    _Pragma("unroll") for (int m = 0; m < 4; m++) _Pragma("unroll") for (int n = 0; n < 4; n++) { \
      const int row = (m0) + _wr * 64 + m * 16 + (_lane >> 4) * 4;                               \
      const int colg = (n0) + _wc * 64 + n * 16 + (_lane & 15);                                  \
      f32x4 v = acc[m][n];                                                                       \
      __VA_ARGS__                                                                                \
    }                                                                                            \
  }

__device__ __forceinline__ void phase_gemm_in(const Params& p, char* smem) {
  char* ws = p.ws;
  const u16* H = (const u16*)(ws + OFF_H);
  u16* Z = (u16*)(ws + OFF_Z);
  u16* VAT = (u16*)(ws + OFF_VAT);
  u16* VBT = (u16*)(ws + OFF_VBT);
  u16* G = (u16*)(p.out);
  const int xcd = blockIdx.x & 7, slot = blockIdx.x >> 3, nslots = gridDim.x >> 3;
  for (int pass = 0; pass < 2; pass++)
  for (int j = slot;; j += nslots) {
    int mt, nt;
    if (!sched_tile(pass == 0 ? 132 : 16, pass == 0 ? 45 : 16, xcd, j, mt, nt)) break;
    f32x4 acc[4][4];
    ACC_ZERO(acc);
    if (pass == 0) {
      const int m0 = mt * 128, n0 = nt * 128;
      gemm_tile(H, HLD, (const u16*)(ws + OFF_WT_IN), HLD, 1024, m0, n0, (u16*)smem, acc);
      u16* T = (u16*)smem;
      if (nt >= 29) {
        epi_stage<false>(acc, T);
        const int ng = n0 - 3712;
        EPI_CHUNKS(T, {
          const int row = m0 + r;
          *(uint4*)(G + (size_t)row * 2048 + ((ng + (row & 15) * 128) & 2047) + c8) = v;
        })
      } else if (nt >= 8 && nt < 12) {
        epi_stage<true>(acc, T);
        EPI_CHUNKS(T, { *(uint4*)(VAT + (size_t)(n0 - 1024 + r) * VLD + m0 + c8) = v; })
      } else if (nt >= 20 && nt < 24) {
        epi_stage<true>(acc, T);
        EPI_CHUNKS(T, { *(uint4*)(VBT + (size_t)(n0 - 2560 + r) * VLD + m0 + c8) = v; })
      } else {
        epi_stage<false>(acc, T);
        EPI_CHUNKS(T, { *(uint4*)(Z + (size_t)(m0 + r) * ZLD + n0 + c8) = v; })
      }
    } else {
      const int m0 = mt * 128, n0 = nt * 128;
      gemm_tile((const u16*)(ws + OFF_MN), HLD, (const u16*)(ws + OFF_WT_MKV), HLD, 1024, m0, n0, (u16*)smem, acc);
      if (nt < 8) {
        u16* MK = (u16*)(ws + OFF_MK);
        float* o = p.out + O_PMK;
        EPI_LOOP(acc, m0, n0, {
          _Pragma("unroll") for (int j = 0; j < 4; j++) {
            o[(size_t)(row + j) * 1024 + colg] = v[j];
            MK[(size_t)(row + j) * HLD + colg] = f2bf(v[j]);
          }
        })
      } else {
        u16* MVT = (u16*)(ws + OFF_MVT);
        float* o = p.out + O_PMV;
        EPI_LOOP(acc, m0, n0 - 1024, {
          _Pragma("unroll") for (int j = 0; j < 4; j++) o[(size_t)(row + j) * 1024 + colg] = v[j];
          uint2 w; w.x = pack2(v[0], v[1]); w.y = pack2(v[2], v[3]);
          const int b = row >> 8, mm = row & 255;
          *(uint2*)(MVT + ((size_t)b * 1024 + colg) * 256 + mm) = w;
        })
      }
    }
  }
}

__device__ __forceinline__ void phase_conv(const Params& p) {
  const u16* Z = (const u16*)(p.ws + OFF_Z);
  u16* QK = (u16*)(p.ws + OFF_H);
  for (int idx = blockIdx.x * 256 + threadIdx.x; idx < NT * 128; idx += gridDim.x * 256) {
    const int row = idx >> 7, c0 = (idx & 127) * 8;
    const bool samp = row >= NP;
    const int t = samp ? ((row - NP) & 31) : (row & 2047);
    const int sb = (row - NP) >> 5;
    float acc[8];
    {
      float4 b0 = *(const float4*)(p.conv_b + c0), b1 = *(const float4*)(p.conv_b + c0 + 4);
      acc[0] = b0.x; acc[1] = b0.y; acc[2] = b0.z; acc[3] = b0.w; acc[4] = b1.x; acc[5] = b1.y; acc[6] = b1.z; acc[7] = b1.w;
    }
    uint4 zw[4];
#pragma unroll
    for (int d = 0; d < 4; d++) zw[d] = *(const uint4*)(Z + (size_t)(row - min(d, t)) * ZLD + 1536 + c0);
#pragma unroll
    for (int d = 0; d < 4; d++) {
      float u[8];
      const uint4 w = zw[d];
      u[0] = lo16(w.x); u[1] = hi16(w.x); u[2] = lo16(w.y); u[3] = hi16(w.y);
      u[4] = lo16(w.z); u[5] = hi16(w.z); u[6] = lo16(w.w); u[7] = hi16(w.w);
      if (t - d < 0) {
        if (samp) {
          const float* pr = p.state_b_conv + (size_t)(sb * 3 + (3 + t - d)) * 1024 + c0;
          float4 a = *(const float4*)pr, b = *(const float4*)(pr + 4);
          u[0] = a.x; u[1] = a.y; u[2] = a.z; u[3] = a.w; u[4] = b.x; u[5] = b.y; u[6] = b.z; u[7] = b.w;
        } else {
#pragma unroll
          for (int e = 0; e < 8; e++) u[e] = 0.f;
        }
      }
      const float* wp = p.conv_w + (3 - d) * 1024 + c0;
      float4 w0 = *(const float4*)wp, w1 = *(const float4*)(wp + 4);
      acc[0] += u[0] * w0.x; acc[1] += u[1] * w0.y; acc[2] += u[2] * w0.z; acc[3] += u[3] * w0.w;
      acc[4] += u[4] * w1.x; acc[5] += u[5] * w1.y; acc[6] += u[6] * w1.z; acc[7] += u[7] * w1.w;
    }
    const float sc = (c0 >= 512) ? 0.08838834764831845f : 1.f;
#pragma unroll
    for (int e = 0; e < 8; e++) acc[e] = acc[e] * sigmoidf_(acc[e]) * sc;
    uint4 o;
    o.x = pack2(acc[0], acc[1]); o.y = pack2(acc[2], acc[3]); o.z = pack2(acc[4], acc[5]); o.w = pack2(acc[6], acc[7]);
    *(uint4*)(QK + (size_t)row * HLD + c0) = o;
  }
}

struct AttnTile { const u16* k; int ldk; const u16* vt; int ldvt; int nvalid; int kpos0; };

template <int DH, class TileFn>
__device__ __forceinline__ void attn_item(const u16* __restrict__ Q, int ldq, int qvalid, u16* __restrict__ O, int ldo, int ntiles,
                          TileFn tf, const float* __restrict__ biasG, int qpos0, float scale, char* smem) {
  constexpr int KLD = DH + 8, NKS = DH / 32, NDT = DH / 16, CPT = DH / 32;
  u16* Ks = (u16*)smem;
  u16* VTs = Ks + 64 * KLD;
  u16* Ps = VTs + DH * 72;
  float* biasS = (float*)(Ps + 4 * 16 * 72);
  int tid = threadIdx.x;
  asm volatile("" : "+v"(tid));
  const int lane = tid & 63, wave = tid >> 6, col = lane & 15, grp = lane >> 4;
  const float L2E = 1.4426950408889634f;
  bf16x8 qf[NKS];
  {
    const int qr = wave * 16 + col;
    const bool ok = qr < qvalid;
#pragma unroll
    for (int ks = 0; ks < NKS; ks++) {
      uint4 w = ok ? *(const uint4*)(Q + (size_t)qr * ldq + ks * 32 + grp * 8) : zero4();
      qf[ks] = *(bf16x8*)&w;
    }
  }
  lds_barrier();
  if (biasG) for (int i = tid; i < 257; i += 256) biasS[i] = biasG[i];
  f32x4 oacc[NDT];
#pragma unroll
  for (int i = 0; i < NDT; i++) oacc[i] = f32x4{0.f, 0.f, 0.f, 0.f};
  float mrun[4], lrun[4];
#pragma unroll
  for (int i = 0; i < 4; i++) { mrun[i] = -INFINITY; lrun[i] = 0.f; }
  uint4 pk_[CPT], pv_[CPT];
  if (DH == 64) {
    const AttnTile T0 = tf(0);
    const int n01 = T0.nvalid - 1;
#pragma unroll
    for (int i = 0; i < CPT; i++) {
      const int c = tid + 256 * i;
      const int key = c / (DH / 8), dc = c % (DH / 8);
      pk_[i] = *(const uint4*)(T0.k + (size_t)min(key, n01) * T0.ldk + dc * 8);
      const int d = c >> 3, kc = c & 7;
      pv_[i] = *(const uint4*)(T0.vt + (size_t)d * T0.ldvt + min(kc * 8, (n01 >> 3) * 8));
    }
  }
#pragma unroll 1
  for (int j = 0; j < ntiles; j++) {
    AttnTile T = tf(j);
    int tidL = tid;
    asm volatile("" : "+v"(tidL));
    lds_barrier();
    const int nvm1 = T.nvalid - 1;
    if (DH == 64) {
#pragma unroll
      for (int i = 0; i < CPT; i++) {
        const int c = tidL + 256 * i;
        const int key = c / (DH / 8), dc = c % (DH / 8);
        *(uint4*)(Ks + key * KLD + dc * 8) = key <= nvm1 ? pk_[i] : zero4();
        const int d = c >> 3, kc = c & 7;
        *(uint4*)(VTs + d * 72 + kc * 8) = (kc * 8 <= nvm1) ? pv_[i] : zero4();
      }
    } else {
      uint4 kv[CPT];
#pragma unroll
      for (int i = 0; i < CPT; i++) {
        const int c = tidL + 256 * i;
        const int key = c / (DH / 8), dc = c % (DH / 8);
        kv[i] = *(const uint4*)(T.k + (size_t)min(key, nvm1) * T.ldk + dc * 8);
      }
#pragma unroll
      for (int i = 0; i < CPT; i++) {
        const int c = tidL + 256 * i;
        const int key = c / (DH / 8), dc = c % (DH / 8);
        *(uint4*)(Ks + key * KLD + dc * 8) = key <= nvm1 ? kv[i] : zero4();
      }
#pragma unroll
      for (int i = 0; i < CPT; i++) {
        const int c = tidL + 256 * i;
        const int d = c >> 3, kc = c & 7;
        kv[i] = *(const uint4*)(T.vt + (size_t)d * T.ldvt + min(kc * 8, (nvm1 >> 3) * 8));
      }
#pragma unroll
      for (int i = 0; i < CPT; i++) {
        const int c = tidL + 256 * i;
        const int d = c >> 3, kc = c & 7;
        *(uint4*)(VTs + d * 72 + kc * 8) = (kc * 8 <= nvm1) ? kv[i] : zero4();
      }
    }
    lds_barrier();
    if (DH == 64 && j + 1 < ntiles) {
      const AttnTile Tn = tf(j + 1);
      const int nn1 = Tn.nvalid - 1;
#pragma unroll
      for (int i = 0; i < CPT; i++) {
        const int c = tidL + 256 * i;
        const int key = c / (DH / 8), dc = c % (DH / 8);
        pk_[i] = *(const uint4*)(Tn.k + (size_t)min(key, nn1) * Tn.ldk + dc * 8);
        const int d = c >> 3, kc = c & 7;
        pv_[i] = *(const uint4*)(Tn.vt + (size_t)d * Tn.ldvt + min(kc * 8, (nn1 >> 3) * 8));
      }
    }
    f32x4 s[4];
#pragma unroll
    for (int n = 0; n < 4; n++) s[n] = f32x4{0.f, 0.f, 0.f, 0.f};
    __builtin_amdgcn_s_setprio(1);
#pragma unroll
    for (int ks = 0; ks < NKS; ks++)
#pragma unroll
      for (int n = 0; n < 4; n++) {
        bf16x8 kf = *(const bf16x8*)(Ks + (n * 16 + col) * KLD + ks * 32 + grp * 8);
        s[n] = MFMA(qf[ks], kf, s[n]);
      }
    __builtin_amdgcn_s_setprio(0);
    float mx[4] = {-INFINITY, -INFINITY, -INFINITY, -INFINITY};
#pragma unroll
    for (int n = 0; n < 4; n++)
#pragma unroll
      for (int i = 0; i < 4; i++) {
        const int key = n * 16 + col;
        float v = s[n][i] * scale;
        if (biasG) {
          int rel = qpos0 + wave * 16 + grp * 4 + i - (T.kpos0 + key);
          rel = min(max(rel, -128), 128) + 128;
          v += biasS[rel];
        }
        if (key >= T.nvalid) v = -INFINITY;
        s[n][i] = v;
        mx[i] = fmaxf(mx[i], v);
      }
    float alpha[4], lsum[4];
#pragma unroll
    for (int i = 0; i < 4; i++) {
      float m2 = fmaxf(mrun[i], row16_max(mx[i]));
      alpha[i] = exp2f((mrun[i] - m2) * L2E);
      mrun[i] = m2;
      lsum[i] = 0.f;
    }
#pragma unroll
    for (int n = 0; n < 4; n++)
#pragma unroll
      for (int i = 0; i < 4; i++) {
        float pv = exp2f((s[n][i] - mrun[i]) * L2E);
        lsum[i] += pv;
        Ps[(wave * 16 + grp * 4 + i) * 72 + n * 16 + col] = f2bf(pv);
      }
#pragma unroll
    for (int i = 0; i < 4; i++) lrun[i] = lrun[i] * alpha[i] + lsum[i];
#pragma unroll
    for (int nd = 0; nd < NDT; nd++)
#pragma unroll
      for (int i = 0; i < 4; i++) oacc[nd][i] *= alpha[i];
    asm volatile("s_waitcnt lgkmcnt(0)" ::: "memory");
    __builtin_amdgcn_s_setprio(1);
#pragma unroll
    for (int k2 = 0; k2 < 2; k2++) {
      bf16x8 pf = *(const bf16x8*)(Ps + (wave * 16 + col) * 72 + k2 * 32 + grp * 8);
#pragma unroll
      for (int nd = 0; nd < NDT; nd++) {
        bf16x8 vf = *(const bf16x8*)(VTs + (nd * 16 + col) * 72 + k2 * 32 + grp * 8);
        oacc[nd] = MFMA(pf, vf, oacc[nd]);
      }
    }
    __builtin_amdgcn_s_setprio(0);
  }
  int rowb = wave * 16 + grp * 4;
  asm volatile("" : "+v"(rowb));
#pragma unroll
  for (int i = 0; i < 4; i++) {
    float l = row16_sum(lrun[i]);
    float inv = __builtin_amdgcn_rcpf(l);
    const int row = rowb + i;
    if (row < qvalid) {
#pragma unroll
      for (int nd = 0; nd < NDT; nd++) O[(size_t)row * ldo + nd * 16 + col] = f2bf(oacc[nd][i] * inv);
    }
  }
}

template <int MODE>
__device__ __forceinline__ void mlstm_item(const Params& p, int item, char* smem) {
  int tid = threadIdx.x;
  asm volatile("" : "+v"(tid));
  const int lane = tid & 63, wave = __builtin_amdgcn_readfirstlane(tid >> 6), col = lane & 15, grp = lane >> 4;
  u16* Z = (u16*)(p.ws + OFF_Z);
  const u16* QK = (const u16*)(p.ws + OFF_H);
  const u16* VBT = (const u16*)(p.ws + OFF_VBT);
  const bool sample = (MODE == 0);
  int h, L, nchunks, row0, bh;
  float *outC = nullptr, *outN = nullptr, *outM = nullptr;
  const u16* CT = nullptr;
  if (MODE == 1) {
    bh = item >> 5; h = bh & 3; L = 64; nchunks = 1; row0 = (bh >> 2) * 2048 + (item & 31) * 64;
    CT = (const u16*)(p.ws + OFF_DELTA) + (size_t)item * 16384;
  } else {
    bh = item; h = bh & 3; L = 32; nchunks = 1; row0 = NP + (bh >> 2) * 32;
    outC = p.out + O_SBC + (size_t)bh * 16384; outN = p.out + O_SBN + bh * 128; outM = p.out + O_SBM + bh;
  }
  u16* Qs = (u16*)smem;
  u16* Ks = Qs + 64 * 136;
  u16* As = Ks;
  u16* KTs = Ks + 64 * 136;
  u16* VTs = KTs + 128 * 72;
  float* fS = (float*)(VTs + 128 * 72);
  float *gS = fS, *MS = fS + 64, *wiS = fS + 128, *emS = fS + 192, *wsS = fS + 256, *denS = fS + 320,
        *ssqS = fS + 384, *nS = fS + 640, *misc = fS + 768;
  f32x4 Cst[8][2];
  const float bif_i = p.b_if[h], bif_f = p.b_if[4 + h];
  lds_barrier();
  if (MODE == 1) {
    if (tid < 128) nS[tid] = ((const float*)(p.ws + OFF_NBUF))[(size_t)item * 128 + tid];
    if (tid == 0) misc[0] = ((const float*)(p.ws + OFF_SCAL))[item * 4 + 2];
  } else if (sample) {
    const float* C0 = p.state_b_C + (size_t)bh * 16384;
    int ibase = grp * 512 + 32 * wave + col;
    asm volatile("" : "+v"(ibase));
#pragma unroll
    for (int mt = 0; mt < 8; mt++)
#pragma unroll
      for (int nn = 0; nn < 2; nn++)
#pragma unroll
        for (int i = 0; i < 4; i++) Cst[mt][nn][i] = C0[(16 * mt + i) * 128 + 16 * nn + ibase];
    if (tid < 128) nS[tid] = p.state_b_n[bh * 128 + tid];
    if (tid == 0) misc[0] = p.state_b_m[bh];
  } else {
#pragma unroll
    for (int mt = 0; mt < 8; mt++)
#pragma unroll
      for (int nn = 0; nn < 2; nn++) Cst[mt][nn] = f32x4{0.f, 0.f, 0.f, 0.f};
    if (tid < 128) nS[tid] = 0.f;
    if (tid == 0) misc[0] = 0.f;
  }
  u16 gpre_i = 0, gpre_f = 0;
  if (wave == 0) {
    const u16* zg = Z + (size_t)(row0 + min(lane, L - 1)) * ZLD + 3584 + h;
    gpre_i = zg[0]; gpre_f = zg[4];
  }
#pragma unroll 1
  for (int c = 0; c < nchunks; c++) {
    int r0 = row0 + c * 64;
    int tidL = tid, colL = col, grpL = grp;
    asm volatile("" : "+v"(r0), "+v"(tidL), "+v"(colL), "+v"(grpL));
    lds_barrier();
    if (wave == 0) {
      const int t = lane;
      float ig = -INFINITY, lf = 0.f;
      {
        const float zi = bf2f(gpre_i) + bif_i, zf = bf2f(gpre_f) + bif_f;
        if (c + 1 < nchunks) {
          const u16* zg = Z + (size_t)(r0 + 64 + t) * ZLD + 3584 + h;
          gpre_i = zg[0]; gpre_f = zg[4];
        }
        if (t < L) {
          ig = zi;
          lf = fminf(zf, 0.f) - log1pf(__expf(-fabsf(zf)));
        }
      }
      float b = lf;
#pragma unroll
      for (int o = 1; o < 64; o <<= 1) { float y = __shfl_up(b, o); if (lane >= o) b += y; }
      const float g = ig - b;
      const float m0 = misc[0];
      float M = g;
#pragma unroll
      for (int o = 1; o < 64; o <<= 1) { float y = __shfl_up(M, o); if (lane >= o) M = fmaxf(M, y); }
      M = fmaxf(M, m0);
      const float Mend = __shfl(M, 63), bl = __shfl(b, 63);
      gS[t] = g; MS[t] = M; wiS[t] = __expf(m0 - M); emS[t] = __expf(-(b + M)); wsS[t] = __expf(g - Mend);
      if (lane == 0) { misc[1] = __expf(m0 - Mend); misc[2] = bl + Mend; }
    }
    lds_barrier();
    {
      uint4 qv[4], kv[4], vv[4];
      const int Lm1 = L - 1;
      const int s_ = tidL & 63;
#pragma unroll
      for (int i = 0; i < 4; i++) {
        const int ci = tidL + 256 * i;
        const int t = ci >> 4, dc = ci & 15;
        qv[i] = *(const uint4*)(QK + (size_t)(r0 + min(t, Lm1)) * HLD + h * 128 + dc * 8);
        const int dk = (tidL >> 6) + 4 * i;
        kv[i] = *(const uint4*)(QK + (size_t)(r0 + min(s_, Lm1)) * HLD + 512 + h * 128 + dk * 8);
        const int vd = ci >> 3, sc = ci & 7;
        vv[i] = *(const uint4*)(VBT + (size_t)(h * 128 + vd) * VLD + r0 + min(sc * 8, (Lm1 >> 3) * 8));
      }
      const float wsv = wsS[s_];
#pragma unroll
      for (int i = 0; i < 4; i++) {
        const int ci = tidL + 256 * i;
        const int t = ci >> 4, dc = ci & 15;
        *(uint4*)(Qs + t * 136 + dc * 8) = t <= Lm1 ? qv[i] : zero4();
        const int dk = (tidL >> 6) + 4 * i;
        const uint4 v = s_ <= Lm1 ? kv[i] : zero4();
        *(uint4*)(Ks + s_ * 136 + dk * 8) = v;
        const u32 w[4] = {v.x, v.y, v.z, v.w};
#pragma unroll
        for (int e = 0; e < 4; e++) {
          KTs[(dk * 8 + 2 * e) * 72 + s_] = f2bf(lo16(w[e]) * wsv);
          KTs[(dk * 8 + 2 * e + 1) * 72 + s_] = f2bf(hi16(w[e]) * wsv);
        }
        const int vd = ci >> 3, sc = ci & 7;
        *(uint4*)(VTs + vd * 72 + sc * 8) = (sc * 8 <= Lm1) ? vv[i] : zero4();
      }
    }
    lds_barrier();
    f32x4 sacc[4];
#pragma unroll
    for (int n = 0; n < 4; n++) sacc[n] = f32x4{0.f, 0.f, 0.f, 0.f};
#pragma unroll
    for (int ks = 0; ks < 4; ks++) {
      bf16x8 qa = *(const bf16x8*)(Qs + (wave * 16 + col) * 136 + ks * 32 + grp * 8);
#pragma unroll
      for (int n = 0; n < 4; n++)
        if (n <= wave) {
          bf16x8 kb = *(const bf16x8*)(Ks + (n * 16 + col) * 136 + ks * 32 + grp * 8);
          sacc[n] = MFMA(qa, kb, sacc[n]);
        }
    }
#pragma unroll
    for (int n = 0; n < 4; n++)
#pragma unroll
      for (int i = 0; i < 4; i++) {
        const int t = wave * 16 + grp * 4 + i, s = n * 16 + col;
        const float dec = __expf(gS[s] - MS[t]);
        sacc[n][i] = (s <= t) ? sacc[n][i] * dec : 0.f;
      }
    lds_barrier();
#pragma unroll
    for (int n = 0; n < 4; n++)
#pragma unroll
      for (int i = 0; i < 4; i++) As[(wave * 16 + grp * 4 + i) * 72 + n * 16 + col] = f2bf(sacc[n][i]);
    lds_barrier();
    {
      f32x4 d1 = f32x4{0.f, 0.f, 0.f, 0.f}, d2 = f32x4{0.f, 0.f, 0.f, 0.f};
      const u32 one2 = (col == 0) ? 0x3F803F80u : 0u;
      uint4 ow = make_uint4(one2, one2, one2, one2);
      bf16x8 ones = *(bf16x8*)&ow;
#pragma unroll
      for (int ks = 0; ks < 2; ks++)
        if (ks == 0 || wave >= 2) {
          bf16x8 aa = *(const bf16x8*)(As + (wave * 16 + col) * 72 + ks * 32 + grp * 8);
          d1 = MFMA(aa, ones, d1);
        }
#pragma unroll
      for (int ks = 0; ks < 4; ks++) {
        uint4 w = zero4();
        if (col == 0) {
          const float* np_ = nS + ks * 32 + grp * 8;
          w.x = pack2(np_[0], np_[1]); w.y = pack2(np_[2], np_[3]); w.z = pack2(np_[4], np_[5]); w.w = pack2(np_[6], np_[7]);
        }
        bf16x8 nf = *(bf16x8*)&w;
        bf16x8 qa = *(const bf16x8*)(Qs + (wave * 16 + col) * 136 + ks * 32 + grp * 8);
        d2 = MFMA(qa, nf, d2);
      }
      if (col == 0) {
#pragma unroll
        for (int i = 0; i < 4; i++) { const int t = wave * 16 + grp * 4 + i; denS[t] = d1[i] + wiS[t] * d2[i]; }
      }
    }
    lds_barrier();
    bf16x8 cb[4][2];
#pragma unroll
    for (int j = 0; j < 4; j++)
#pragma unroll
      for (int nn = 0; nn < 2; nn++) {
        uint4 w;
        if (MODE == 1) {
          w = *(const uint4*)(CT + (size_t)(32 * wave + 16 * nn + col) * 128 + 32 * j + grp * 8);
        } else {
          w.x = pack2(Cst[2 * j][nn][0], Cst[2 * j][nn][1]);
          w.y = pack2(Cst[2 * j][nn][2], Cst[2 * j][nn][3]);
          w.z = pack2(Cst[2 * j + 1][nn][0], Cst[2 * j + 1][nn][1]);
          w.w = pack2(Cst[2 * j + 1][nn][2], Cst[2 * j + 1][nn][3]);
        }
        cb[j][nn] = *(bf16x8*)&w;
      }
    u32 hreg[4][4];
#pragma unroll
    for (int m = 0; m < 4; m++) {
      f32x4 av[2], qc[2];
#pragma unroll
      for (int nn = 0; nn < 2; nn++) { av[nn] = f32x4{0.f, 0.f, 0.f, 0.f}; qc[nn] = f32x4{0.f, 0.f, 0.f, 0.f}; }
#pragma unroll
      for (int ks = 0; ks < 2; ks++)
        if (ks == 0 || m >= 2) {
          bf16x8 aa = *(const bf16x8*)(As + (m * 16 + col) * 72 + ks * 32 + grp * 8);
#pragma unroll
          for (int nn = 0; nn < 2; nn++) {
            bf16x8 vb = *(const bf16x8*)(VTs + (32 * wave + 16 * nn + col) * 72 + ks * 32 + grp * 8);
            av[nn] = MFMA(aa, vb, av[nn]);
          }
        }
#pragma unroll
      for (int j = 0; j < 4; j++) {
        uint4 w;
        if (MODE == 1) {
          w = *(const uint4*)(Qs + (m * 16 + col) * 136 + 32 * j + 8 * grp);
        } else {
          uint2 a0 = *(const uint2*)(Qs + (m * 16 + col) * 136 + 32 * j + 4 * grp);
          uint2 a1 = *(const uint2*)(Qs + (m * 16 + col) * 136 + 32 * j + 16 + 4 * grp);
          w = make_uint4(a0.x, a0.y, a1.x, a1.y);
        }
        bf16x8 qp = *(bf16x8*)&w;
#pragma unroll
        for (int nn = 0; nn < 2; nn++) qc[nn] = MFMA(qp, cb[j][nn], qc[nn]);
      }
#pragma unroll
      for (int i = 0; i < 4; i++) {
        const int t = m * 16 + grp * 4 + i;
        const float wi = wiS[t];
        const float inv = 1.f / fmaxf(fabsf(denS[t]), emS[t]);
        const float hv0 = (av[0][i] + wi * qc[0][i]) * inv, hv1 = (av[1][i] + wi * qc[1][i]) * inv;
        hreg[m][i] = pack2(hv0, hv1);
        float s2 = hv0 * hv0 + hv1 * hv1;
        s2 = row16_sum(s2);
        if (col == 0) ssqS[wave * 64 + t] = s2;
      }
    }
    lds_barrier();
    {
      u32 obv[4][4];
      float gh[2];
#pragma unroll
      for (int nn = 0; nn < 2; nn++) gh[nn] = p.g_head[h * 128 + 32 * wave + 16 * nn + colL];
#pragma unroll
      for (int m = 0; m < 4; m++)
#pragma unroll
        for (int i = 0; i < 4; i++) {
          const int t = m * 16 + grpL * 4 + i;
          const u16* zp = Z + (size_t)(r0 + min(t, L - 1)) * ZLD + 3072 + h * 128 + 32 * wave + colL;
          obv[m][i] = (u32)zp[0] | ((u32)zp[16] << 16);
        }
#pragma unroll
      for (int m = 0; m < 4; m++)
#pragma unroll
        for (int i = 0; i < 4; i++) {
          const int t = m * 16 + grpL * 4 + i;
          if (t < L) {
            const float tot = ssqS[t] + ssqS[64 + t] + ssqS[128 + t] + ssqS[192 + t];
            const float r = rsqrtf(tot * (1.f / 128.f) + 1e-6f);
#pragma unroll
            for (int nn = 0; nn < 2; nn++) {
              const int vd = 32 * wave + 16 * nn + colL;
              const float o = (nn ? hi16(hreg[m][i]) : lo16(hreg[m][i])) * r * gh[nn] * sigmoidf_(nn ? hi16(obv[m][i]) : lo16(obv[m][i]));
              Z[(size_t)(r0 + t) * ZLD + 2560 + h * 128 + vd] = f2bf(o);
            }
          }
        }
    }
    if (MODE == 0) {
    const float a0 = misc[1];
#pragma unroll
    for (int mt = 0; mt < 8; mt++)
#pragma unroll
      for (int nn = 0; nn < 2; nn++)
#pragma unroll
        for (int i = 0; i < 4; i++) Cst[mt][nn][i] *= a0;
#pragma unroll
    for (int ks = 0; ks < 2; ks++)
#pragma unroll
      for (int nn = 0; nn < 2; nn++) {
        bf16x8 vb = *(const bf16x8*)(VTs + (32 * wave + 16 * nn + col) * 72 + ks * 32 + grp * 8);
#pragma unroll
        for (int mt = 0; mt < 8; mt++) {
          bf16x8 ka = *(const bf16x8*)(KTs + (mt * 16 + col) * 72 + ks * 32 + grp * 8);
          Cst[mt][nn] = MFMA(ka, vb, Cst[mt][nn]);
        }
      }
    if (tid < 128) {
      float acc = 0.f;
#pragma unroll
      for (int s8 = 0; s8 < 8; s8++) {
        uint4 v = *(const uint4*)(KTs + tid * 72 + s8 * 8);
        acc += lo16(v.x) + hi16(v.x) + lo16(v.y) + hi16(v.y) + lo16(v.z) + hi16(v.z) + lo16(v.w) + hi16(v.w);
      }
      nS[tid] = a0 * nS[tid] + acc;
    }
    if (tid == 0) misc[0] = misc[2];
    }
  }
  lds_barrier();
  if (MODE == 1) return;
  int obase = grp * 512 + 32 * wave + col;
  asm volatile("" : "+v"(obase));
#pragma unroll
  for (int mt = 0; mt < 8; mt++)
#pragma unroll
    for (int nn = 0; nn < 2; nn++)
#pragma unroll
      for (int i = 0; i < 4; i++) outC[(16 * mt + i) * 128 + 16 * nn + obase] = Cst[mt][nn][i];
  if (tid < 128) outN[tid] = nS[tid];
  if (tid == 0) *outM = misc[0];
}

__device__ __forceinline__ void mlstm_delta_item(const Params& p, int item, char* smem) {
  int tid = threadIdx.x;
  asm volatile("" : "+v"(tid));
  const int lane = tid & 63, wave = __builtin_amdgcn_readfirstlane(tid >> 6), col = lane & 15, grp = lane >> 4;
  const int wr = wave >> 1, wc = wave & 1;
  const u16* Z = (const u16*)(p.ws + OFF_Z);
  const u16* QK = (const u16*)(p.ws + OFF_H);
  const u16* VBT = (const u16*)(p.ws + OFF_VBT);
  const int bh = item >> 5, h = bh & 3;
  const int r0 = (bh >> 2) * 2048 + (item & 31) * 64;
  u16* T = (u16*)smem;
  u16* KTs = T + 128 * TLD;
  u16* VTs = KTs + 128 * 72;
  float* wsS = (float*)(VTs + 128 * 72);
  lds_barrier();
  if (wave == 0) {
    const u16* zg = Z + (size_t)(r0 + lane) * ZLD + 3584 + h;
    const u16 zi16 = zg[0], zf16 = zg[4];
    const float ig = bf2f(zi16) + p.b_if[h], zf = bf2f(zf16) + p.b_if[4 + h];
    const float lf = fminf(zf, 0.f) - log1pf(__expf(-fabsf(zf)));
    float b = lf;
#pragma unroll
    for (int o = 1; o < 64; o <<= 1) { float y = __shfl_up(b, o); if (lane >= o) b += y; }
    const float g = ig - b;
    float gm = g;
#pragma unroll
    for (int o = 32; o >= 1; o >>= 1) gm = fmaxf(gm, __shfl_xor(gm, o));
    wsS[lane] = __expf(g - gm);
    if (lane == 63) {
      float* sc = (float*)(p.ws + OFF_SCAL) + item * 4;
      sc[0] = b; sc[1] = gm;
    }
  }
  lds_barrier();
  uint4 kv[4], vv[4];
  const int s_ = tid & 63;
#pragma unroll
  for (int i = 0; i < 4; i++) {
    const int dk = (tid >> 6) + 4 * i;
    kv[i] = *(const uint4*)(QK + (size_t)(r0 + s_) * HLD + 512 + h * 128 + dk * 8);
    const int ci = tid + 256 * i;
    vv[i] = *(const uint4*)(VBT + (size_t)(h * 128 + (ci >> 3)) * VLD + r0 + (ci & 7) * 8);
  }
  const float wsv = wsS[s_];
#pragma unroll
  for (int i = 0; i < 4; i++) {
    const int dk = (tid >> 6) + 4 * i;
    const u32 w[4] = {kv[i].x, kv[i].y, kv[i].z, kv[i].w};
#pragma unroll
    for (int e = 0; e < 4; e++) {
      KTs[(dk * 8 + 2 * e) * 72 + s_] = f2bf(lo16(w[e]) * wsv);
      KTs[(dk * 8 + 2 * e + 1) * 72 + s_] = f2bf(hi16(w[e]) * wsv);
    }
    const int ci = tid + 256 * i;
    *(uint4*)(VTs + (ci >> 3) * 72 + (ci & 7) * 8) = vv[i];
  }
  lds_barrier();
  f32x4 acc[4][4];
  ACC_ZERO(acc);
#pragma unroll
  for (int ks = 0; ks < 2; ks++) {
    bf16x8 af[4], bq[4];
#pragma unroll
    for (int m = 0; m < 4; m++) af[m] = *(const bf16x8*)(VTs + (wr * 64 + m * 16 + col) * 72 + ks * 32 + grp * 8);
#pragma unroll
    for (int n = 0; n < 4; n++) bq[n] = *(const bf16x8*)(KTs + (wc * 64 + n * 16 + col) * 72 + ks * 32 + grp * 8);
#pragma unroll
    for (int m = 0; m < 4; m++)
#pragma unroll
      for (int n = 0; n < 4; n++) acc[m][n] = MFMA(af[m], bq[n], acc[m][n]);
  }
  if (tid < 128) {
    float a = 0.f;
#pragma unroll
    for (int s8 = 0; s8 < 8; s8++) {
      uint4 v = *(const uint4*)(KTs + tid * 72 + s8 * 8);
      a += lo16(v.x) + hi16(v.x) + lo16(v.y) + hi16(v.y) + lo16(v.z) + hi16(v.z) + lo16(v.w) + hi16(v.w);
    }
    ((float*)(p.ws + OFF_NBUF))[(size_t)item * 128 + tid] = a;
  }
  u16* D = (u16*)(p.ws + OFF_DELTA) + (size_t)item * 16384;
  epi_stage<false>(acc, T);
  EPI_CHUNKS(T, { *(uint4*)(D + r * 128 + c8) = v; })
}

__device__ __forceinline__ void mlstm_scan(const Params& p) {
  const int tid = threadIdx.x;
  float* SC = (float*)(p.ws + OFF_SCAL);
  for (int it = blockIdx.x; it < 256; it += gridDim.x) {
    const int bh = it >> 3, sl = it & 7;
    u16* D = (u16*)(p.ws + OFF_DELTA) + (size_t)bh * 32 * 16384 + sl * 2048 + tid * 8;
    float* NB = (float*)(p.ws + OFF_NBUF) + (size_t)bh * 32 * 128;
    float st[8], nst = 0.f, m0 = 0.f;
#pragma unroll
    for (int e = 0; e < 8; e++) st[e] = 0.f;
    uint4 cur = *(const uint4*)D;
    float ncur = (sl == 0 && tid < 128) ? NB[tid] : 0.f;
    float2 sc = *(const float2*)(SC + (bh * 32) * 4);
#pragma unroll 1
    for (int c = 0; c < 32; c++) {
      uint4 nxt = cur; float nnxt = ncur; float2 scn = sc;
      if (c + 1 < 32) {
        nxt = *(const uint4*)(D + (size_t)(c + 1) * 16384);
        if (sl == 0 && tid < 128) nnxt = NB[(c + 1) * 128 + tid];
        scn = *(const float2*)(SC + (bh * 32 + c + 1) * 4);
      }
      uint4 o;
      o.x = pack2(st[0], st[1]); o.y = pack2(st[2], st[3]); o.z = pack2(st[4], st[5]); o.w = pack2(st[6], st[7]);
      *(uint4*)(D + (size_t)c * 16384) = o;
      if (sl == 0) {
        if (tid < 128) NB[c * 128 + tid] = nst;
        if (tid == 0) SC[(bh * 32 + c) * 4 + 2] = m0;
      }
      const float bl = sc.x, gm = sc.y;
      const float mx = fmaxf(m0, gm);
      const float al = __expf(m0 - mx), be = __expf(gm - mx);
      st[0] = al * st[0] + be * lo16(cur.x); st[1] = al * st[1] + be * hi16(cur.x);
      st[2] = al * st[2] + be * lo16(cur.y); st[3] = al * st[3] + be * hi16(cur.y);
      st[4] = al * st[4] + be * lo16(cur.z); st[5] = al * st[5] + be * hi16(cur.z);
      st[6] = al * st[6] + be * lo16(cur.w); st[7] = al * st[7] + be * hi16(cur.w);
      nst = al * nst + be * ncur;
      m0 = bl + mx;
      cur = nxt; ncur = nnxt; sc = scn;
    }
    const int vd = sl * 16 + (tid >> 4), kd0 = (tid & 15) * 8;
    float* oc = p.out + O_PBC + (size_t)bh * 16384;
#pragma unroll
    for (int e = 0; e < 8; e++) oc[(kd0 + e) * 128 + vd] = st[e];
    if (sl == 0) {
      if (tid < 128) p.out[O_PBN + bh * 128 + tid] = nst;
      if (tid == 0) p.out[O_PBM + bh] = m0;
    }
  }
}

__device__ __forceinline__ void phase_mixers(const Params& p, char* smem, int* s_item) {
  char* ws = p.ws;
  u16* Z = (u16*)(ws + OFF_Z);
  const u16* VAT = (const u16*)(ws + OFF_VAT);
  const int tid = threadIdx.x;
  {
    const size_t gs = (size_t)gridDim.x * 256, g0 = (size_t)blockIdx.x * 256 + tid;
    for (size_t i = g0; i < 2097152; i += gs) {
      int f = i & 511; int r = (i >> 9) & 511; int b = i >> 18;
      p.out[O_PAK + i] = bf2f(Z[(size_t)(b * 2048 + 1536 + r) * ZLD + 512 + f]);
    }
    for (size_t i = g0; i < 2097152; i += gs) {
      int r = i & 511; int f = (i >> 9) & 511; int b = i >> 18;
      p.out[O_PAV + ((size_t)(b * 512 + r) * 512 + f)] = bf2f(VAT[(size_t)f * VLD + b * 2048 + 1536 + r]);
    }
    for (size_t i = g0; i < 262144; i += gs) {
      int f = i & 511; int r = i >> 9;
      p.out[O_SAK + i] = bf2f(Z[(size_t)(NP + r) * ZLD + 512 + f]);
    }
    for (size_t i = g0; i < 262144; i += gs) {
      int r = i & 511; int f = i >> 9;
      p.out[O_SAV + (size_t)r * 512 + f] = bf2f(VAT[(size_t)f * VLD + NP + r]);
    }
    for (size_t i = g0; i < 24576; i += gs) {
      int c = i & 1023; int j = (i >> 10) % 3; int b = i / 3072;
      p.out[O_PBCONV + i] = bf2f(Z[(size_t)(b * 2048 + 2045 + j) * ZLD + 1536 + c]);
    }
    for (size_t i = g0; i < 49152; i += gs) {
      int c = i & 1023; int j = (i >> 10) % 3; int sb = i / 3072;
      p.out[O_SBCONV + i] = bf2f(Z[(size_t)(NP + sb * 32 + 29 + j) * ZLD + 1536 + c]);
    }
  }
  int* ctr = (int*)(ws + OFF_CTR);
  const int total = 1088 + 2048 + 128;
  for (;;) {
    __syncthreads();
    if (tid == 0) *s_item = atomicAdd(ctr, 1);
    __syncthreads();
    const int it = __builtin_amdgcn_readfirstlane(*s_item);
    if (it >= total) break;
    if (it < 1024) {
      mlstm_delta_item(p, it, smem);
    } else if (it < 1088) {
      mlstm_item<0>(p, it - 1024, smem);
    } else if (it < 1088 + 2048) {
      const int q = it - 1088;
      const int h = q & 7, c = (q >> 3) & 31, b = q >> 8;
      const int nb = c < 8 ? c : 8;
      u16* Qp = Z + (size_t)(b * 2048 + c * 64) * ZLD + h * 64;
      auto tf = [=](int j) {
        const int cc = c - nb + j;
        AttnTile T;
        T.k = Z + (size_t)(b * 2048 + cc * 64) * ZLD + 512 + h * 64; T.ldk = ZLD;
        T.vt = VAT + (size_t)(h * 64) * VLD + b * 2048 + cc * 64; T.ldvt = VLD;
        T.nvalid = 64; T.kpos0 = cc * 64;
        return T;
      };
      attn_item<64>(Qp, ZLD, 64, Qp, ZLD, nb + 1, tf, p.rel_bias + h * 257, c * 64, 0.125f, smem);
    } else {
      const int q = it - 1088 - 2048;
      const int h = q & 7, sb = q >> 3;
      const u16* KC = (const u16*)(ws + OFF_KC);
      const u16* VCT = (const u16*)(ws + OFF_VCT);
      u16* Qp = Z + (size_t)(NP + sb * 32) * ZLD + h * 64;
      auto tf = [=](int j) {
        AttnTile T;
        if (j < 8) {
          T.k = KC + (size_t)(sb * 512 + j * 64) * 512 + h * 64; T.ldk = 512;
          T.vt = VCT + (size_t)(sb * 512 + h * 64) * 512 + j * 64; T.ldvt = 512;
          T.nvalid = 64; T.kpos0 = j * 64;
        } else {
          T.k = Z + (size_t)(NP + sb * 32) * ZLD + 512 + h * 64; T.ldk = ZLD;
          T.vt = VAT + (size_t)(h * 64) * VLD + NP + sb * 32; T.ldvt = VLD;
          T.nvalid = 32; T.kpos0 = 512;
        }
        return T;
      };
      attn_item<64>(Qp, ZLD, 32, Qp, ZLD, 9, tf, p.rel_bias + h * 257, 512, 0.125f, smem);
    }
  }
}

__device__ __forceinline__ void phase_mlstm_out(const Params& p, char* smem) {
  for (int it = blockIdx.x; it < 1024; it += gridDim.x) mlstm_item<1>(p, it, smem);
}

__device__ __forceinline__ void phase_mixed(const Params& p, char* smem) {
  char* ws = p.ws;
  const u16* Z = (const u16*)(ws + OFF_Z);
  const u16* G = (const u16*)p.out;
  u16* Hm = (u16*)(ws + OFF_H);
  const int xcd = blockIdx.x & 7, slot = blockIdx.x >> 3, nslots = gridDim.x >> 3;
#pragma unroll 1
  for (int j = slot;; j += nslots) {
    int mt, nt;
    if (!sched_tile(132, 8, xcd, j, mt, nt)) break;
    const int m0 = mt * 128, n0 = nt * 128;
    f32x4 acc[4][4];
    ACC_ZERO(acc);
    gemm_tile(Z, ZLD, (const u16*)(ws + OFF_WT_AUP), WLD5, 512, m0, n0, (u16*)smem, acc);
    {
      u16* T = (u16*)smem;
      epi_stage<false>(acc, T);
      EPI_CHUNKS(T, {
        const int row = m0 + r;
        const uint4 g = *(const uint4*)(G + (size_t)row * 2048 + ((n0 + (row & 15) * 128) & 2047) + c8);
        uint4 o;
        o.x = pack2(lo16(v.x) * sigmoidf_(lo16(g.x)), hi16(v.x) * sigmoidf_(hi16(g.x)));
        o.y = pack2(lo16(v.y) * sigmoidf_(lo16(g.y)), hi16(v.y) * sigmoidf_(hi16(g.y)));
        o.z = pack2(lo16(v.z) * sigmoidf_(lo16(g.z)), hi16(v.z) * sigmoidf_(hi16(g.z)));
        o.w = pack2(lo16(v.w) * sigmoidf_(lo16(g.w)), hi16(v.w) * sigmoidf_(hi16(g.w)));
        *(uint4*)(Hm + (size_t)row * HLD + n0 + c8) = o;
      })
    }
  }
#pragma unroll 1
  for (int j = slot;; j += nslots) {
    int mt, nt;
    if (!sched_tile(132, 8, xcd, j, mt, nt)) break;
    const int m0 = mt * 128, n0 = nt * 128;
    f32x4 acc[4][4];
    ACC_ZERO(acc);
    gemm_tile(Z + 2560, ZLD, (const u16*)(ws + OFF_WT_BUP), WLD5, 512, m0, n0, (u16*)smem, acc);
    {
      u16* T = (u16*)smem;
      epi_stage<false>(acc, T);
      EPI_CHUNKS(T, {
        const int row = m0 + r;
        const uint4 g = *(const uint4*)(G + (size_t)row * 2048 + ((1024 + n0 + (row & 15) * 128) & 2047) + c8);
        const uint4 hp = *(const uint4*)(Hm + (size_t)row * HLD + n0 + c8);
        uint4 o;
        o.x = pack2(lo16(hp.x) + lo16(v.x) * sigmoidf_(lo16(g.x)), hi16(hp.x) + hi16(v.x) * sigmoidf_(hi16(g.x)));
        o.y = pack2(lo16(hp.y) + lo16(v.y) * sigmoidf_(lo16(g.y)), hi16(hp.y) + hi16(v.y) * sigmoidf_(hi16(g.y)));
        o.z = pack2(lo16(hp.z) + lo16(v.z) * sigmoidf_(lo16(g.z)), hi16(hp.z) + hi16(v.z) * sigmoidf_(hi16(g.z)));
        o.w = pack2(lo16(hp.w) + lo16(v.w) * sigmoidf_(lo16(g.w)), hi16(hp.w) + hi16(v.w) * sigmoidf_(hi16(g.w)));
        *(uint4*)(Hm + (size_t)row * HLD + n0 + c8) = o;
      })
    }
  }
  cvt_fp8(p.peer_u, (unsigned char*)(ws + OFF_PU), 16384ull * 1024, 64.f);
  cvt_fp8(p.peer_v, (unsigned char*)(ws + OFF_PU) + 1024, 16384ull * 1024, 16.f);
}

__device__ __forceinline__ void phase_gemm_generic(const Params& p, char* smem, const u16* A, const u16* Bt, int ntn, int mode, u16* dst,
                                   int ldd) {
  float* y = p.out;
  const int xcd = blockIdx.x & 7, slot = blockIdx.x >> 3, nslots = gridDim.x >> 3;
#pragma unroll 1
  for (int j = slot;; j += nslots) {
    int mt, nt;
    if (!sched_tile(132, ntn, xcd, j, mt, nt)) break;
    const int m0 = mt * 128, n0 = nt * 128;
    f32x4 acc[4][4];
    ACC_ZERO(acc);
    gemm_tile(A, HLD, Bt, HLD, 1024, m0, n0, (u16*)smem, acc);
    if (mode == 0 || mode == 1) {
      const float* xin = (mode == 1) ? y : (m0 < NP ? p.x_prompt : p.x_sample - (size_t)NP * 1024);
      _Pragma("unroll") for (int mh = 0; mh < 2; mh++) {
        float xv[2][4][4];
        EPI_LOOP(acc, m0, n0, {
          if ((m >> 1) == mh) { _Pragma("unroll") for (int j = 0; j < 4; j++) xv[m & 1][n][j] = xin[(size_t)(row + j) * 1024 + colg]; }
        })
        EPI_LOOP(acc, m0, n0, {
          if ((m >> 1) == mh) { _Pragma("unroll") for (int j = 0; j < 4; j++) y[(size_t)(row + j) * 1024 + colg] = xv[m & 1][n][j] + v[j]; }
        })
      }
    } else {
      u16* T = (u16*)smem;
      epi_stage<false>(acc, T);
      EPI_CHUNKS(T, { *(uint4*)(dst + (size_t)(m0 + r) * ldd + n0 + c8) = v; })
    }
  }
}

__device__ __forceinline__ void phase_norm(const Params& p, const float* g) {
  const int lane = threadIdx.x & 63, gw = blockIdx.x * 4 + (threadIdx.x >> 6), nw = gridDim.x * 4;
  for (int r = gw; r < NT; r += nw)
    rms_row_to_bf16(p.out + (size_t)r * 1024, g, (u16*)(p.ws + OFF_H) + (size_t)r * HLD, lane);
}

__device__ __forceinline__ void phase_cross(const Params& p, char* smem) {
  char* ws = p.ws;
  u16* QC = (u16*)(ws + OFF_QC);
  const u16* MK = (const u16*)(ws + OFF_MK);
  const u16* MVT = (const u16*)(ws + OFF_MVT);
  for (int it = blockIdx.x; it < 1024 + 64; it += gridDim.x) {
    int bb, tile, h, row0, qv;
    if (it < 1024) { h = it & 3; tile = (it >> 2) & 31; bb = it >> 7; row0 = bb * 2048 + tile * 64; qv = 64; }
    else { int q = it - 1024; h = q & 3; bb = 8 + (q >> 2); row0 = NP + (bb - 8) * 32; qv = 32; }
    u16* Qp = QC + (size_t)row0 * HLD + h * 256;
    auto tf = [=](int j) {
      AttnTile T;
      T.k = MK + (size_t)(bb * 256 + j * 64) * HLD + h * 256; T.ldk = HLD;
      T.vt = MVT + ((size_t)bb * 1024 + h * 256) * 256 + j * 64; T.ldvt = 256;
      T.nvalid = 64; T.kpos0 = 0;
      return T;
    };
    attn_item<256>(Qp, HLD, qv, Qp, HLD, 4, tf, nullptr, 0, 0.0625f, smem);
  }
}

__constant__ unsigned char STAIR[64] = {
    0x00, 0x01, 0x02, 0x03, 0x04, 0x05, 0x06, 0x07, 0x08, 0x09, 0x0A, 0x0B, 0x0C, 0x0D, 0x0E, 0x0F,
    0x10, 0x11, 0x12, 0x13, 0x14, 0x15, 0x16, 0x17,
    0x20, 0x21, 0x22, 0x23, 0x24,
    0x30, 0x31, 0x32, 0x33,
    0x40, 0x41, 0x42,
    0x50, 0x51, 0x60, 0x61, 0x70, 0x71,
    0x80, 0x90, 0xA0, 0xB0, 0xC0, 0xD0, 0xE0, 0xF0,
    0xFF, 0xFF, 0xFF, 0xFF, 0xFF, 0xFF, 0xFF, 0xFF, 0xFF, 0xFF, 0xFF, 0xFF, 0xFF, 0xFF};

#define INS16(L, x)                                                        \
  _Pragma("unroll") for (int _q = 0; _q < 16; _q++) {                       \
    const u32 _hi = umax2(L[_q], x);                                        \
    x = L[_q] < x ? L[_q] : x;                                              \
    L[_q] = _hi;                                                            \
  }
__device__ __forceinline__ void phase_route(const Params& p, char* smem) {
  char* ws = p.ws;
  const u16* PQ = (const u16*)(ws + OFF_PQ);
  const u16* SUBK = (const u16*)(ws + OFF_SUBK);
  float2* ROUTE = (float2*)(ws + OFF_ROUTE);
  int tid = threadIdx.x;
  asm volatile("" : "+v"(tid));
  const int lane = tid & 63, wave = __builtin_amdgcn_readfirstlane(tid >> 6), col = lane & 15, grp = lane >> 4;
  u16* keyS = (u16*)smem;
  u32* listS = (u32*)smem;
  u32* stairS = (u32*)(smem + 66560);
  int* cntS = (int*)(smem + 66560 + 256);
  if (tid < 64) stairS[tid] = STAIR[tid];
#pragma unroll 1
  for (int it = blockIdx.x; it < NT / 16; it += gridDim.x) {
    const int tok0 = it * 16;
    __syncthreads();
#pragma unroll 1
    for (int q = 0; q < 4; q++) {
      const int hc = wave * 4 + q;
      f32x4 acc[8];
#pragma unroll
      for (int nt = 0; nt < 8; nt++) acc[nt] = f32x4{0.f, 0.f, 0.f, 0.f};
#pragma unroll
      for (int ks = 0; ks < 4; ks++) {
        bf16x8 a = *(const bf16x8*)(PQ + (size_t)(tok0 + col) * PQLD + hc * 128 + ks * 32 + grp * 8);
#pragma unroll
        for (int nt = 0; nt < 8; nt++) {
          bf16x8 bb = *(const bf16x8*)(SUBK + (size_t)(hc * 128 + nt * 16 + col) * 128 + ks * 32 + grp * 8);
          acc[nt] = MFMA(a, bb, acc[nt]);
        }
      }
#pragma unroll
      for (int nt = 0; nt < 8; nt++)
#pragma unroll
        for (int i = 0; i < 4; i++)
          keyS[((grp * 4 + i) * 16 + hc) * 130 + nt * 16 + col] = (u16)(ordk(acc[nt][i]) >> 16);
    }
    __syncthreads();
    u32 L[16];
#pragma unroll
    for (int q = 0; q < 16; q++) L[q] = 0u;
    {
      const u32* rowp = (const u32*)(keyS + tid * 130);
#pragma unroll 4
      for (int j2 = 0; j2 < 64; j2++) {
        const u32 w = rowp[j2];
        u32 x0 = (w << 16) | (u32)(127 - 2 * j2);
        u32 x1 = (w & 0xffff0000u) | (u32)(126 - 2 * j2);
        INS16(L, x0)
        INS16(L, x1)
      }
    }
    __syncthreads();
#pragma unroll
    for (int q = 0; q < 4; q++)
      *(uint4*)(listS + tid * 16 + q * 4) = make_uint4(L[4 * q], L[4 * q + 1], L[4 * q + 2], L[4 * q + 3]);
    __syncthreads();
    int eidx[16];
    float gate[16];
    if (tid < 128) {
      const int token = tid >> 3, head = tid & 7;
      const u32* la = listS + (token * 16 + head * 2) * 16;
      const u32* lb = la + 16;
      float av[16], bv[16];
#pragma unroll
      for (int q = 0; q < 4; q++) {
        const uint4 wa = *(const uint4*)(la + 4 * q), wb = *(const uint4*)(lb + 4 * q);
        av[4 * q] = unordk(wa.x & 0xffff0000u); av[4 * q + 1] = unordk(wa.y & 0xffff0000u);
        av[4 * q + 2] = unordk(wa.z & 0xffff0000u); av[4 * q + 3] = unordk(wa.w & 0xffff0000u);
        bv[4 * q] = unordk(wb.x & 0xffff0000u); bv[4 * q + 1] = unordk(wb.y & 0xffff0000u);
        bv[4 * q + 2] = unordk(wb.z & 0xffff0000u); bv[4 * q + 3] = unordk(wb.w & 0xffff0000u);
      }
      u32 T[16];
#pragma unroll
      for (int q = 0; q < 16; q++) T[q] = 0u;
      {
        int slot = 0;
#pragma unroll
        for (int ia = 0; ia < 16; ia++)
#pragma unroll
          for (int ib = 0; ib < 16; ib++)
            if ((ia + 1) * (ib + 1) <= 16) {
              u32 x = (ordk(av[ia] + bv[ib]) & ~63u) | (u32)(63 - slot);
              INS16(T, x)
              slot++;
            }
      }
      float e[16], ssum = 0.f;
      const float vmax = unordk(T[0] & ~63u);
#pragma unroll
      for (int k = 0; k < 16; k++) { e[k] = __expf(unordk(T[k] & ~63u) - vmax); ssum += e[k]; }
      const float rs = __builtin_amdgcn_rcpf(ssum);
#pragma unroll
      for (int k = 0; k < 16; k++) {
        const u32 code = stairS[63 - (int)(T[k] & 63u)];
        const int ia = 127 - (int)(la[(code >> 4) & 15] & 127u), ib = 127 - (int)(lb[code & 15] & 127u);
        eidx[k] = ia * 128 + ib;
        gate[k] = e[k] * rs;
      }
#pragma unroll
      for (int b = 0; b < 8; b++) {
        int c = 0;
#pragma unroll
        for (int k = 0; k < 16; k++) c += ((eidx[k] >> 11) == b) ? 1 : 0;
        cntS[(token * 8 + head) * 8 + b] = c;
      }
    }
    __syncthreads();
    if (tid < 128) {
      const int token = tid >> 3, head = tid & 7;
      int base[8];
      {
        int run = 0;
#pragma unroll
        for (int b = 0; b < 8; b++) {
          int mine = 0, tot = 0;
#pragma unroll
          for (int hh = 0; hh < 8; hh++) {
            const int c = cntS[(token * 8 + hh) * 8 + b];
            mine += (hh < head) ? c : 0;
            tot += c;
          }
          base[b] = run + mine;
          run += tot;
        }
      }
      float2* ro = ROUTE + (size_t)(tok0 + token) * 128;
#pragma unroll
      for (int k = 0; k < 16; k++) {
        const int bk = eidx[k] >> 11;
        int pos = 0;
#pragma unroll
        for (int b = 0; b < 8; b++) pos += (bk == b) ? base[b] : 0;
#pragma unroll
        for (int k2 = 0; k2 < 16; k2++)
          if (k2 < k) pos += ((eidx[k2] >> 11) == bk) ? 1 : 0;
        ro[pos] = make_float2(gate[k], __int_as_float(eidx[k]));
      }
    }
  }
}
#undef INS16

__device__ __forceinline__ void unpack8(uint4 w, float* f) {
  f[0] = lo16(w.x); f[1] = hi16(w.x); f[2] = lo16(w.y); f[3] = hi16(w.y);
  f[4] = lo16(w.z); f[5] = hi16(w.z); f[6] = lo16(w.w); f[7] = hi16(w.w);
}

__device__ __forceinline__ void unpack_fp8x16(uint4 w, float* f) {
  typedef float f2_ __attribute__((ext_vector_type(2)));
  f2_ t;
  t = __builtin_amdgcn_cvt_pk_f32_fp8((int)w.x, false); f[0] = t.x; f[1] = t.y;
  t = __builtin_amdgcn_cvt_pk_f32_fp8((int)w.x, true); f[2] = t.x; f[3] = t.y;
  t = __builtin_amdgcn_cvt_pk_f32_fp8((int)w.y, false); f[4] = t.x; f[5] = t.y;
  t = __builtin_amdgcn_cvt_pk_f32_fp8((int)w.y, true); f[6] = t.x; f[7] = t.y;
  t = __builtin_amdgcn_cvt_pk_f32_fp8((int)w.z, false); f[8] = t.x; f[9] = t.y;
  t = __builtin_amdgcn_cvt_pk_f32_fp8((int)w.z, true); f[10] = t.x; f[11] = t.y;
  t = __builtin_amdgcn_cvt_pk_f32_fp8((int)w.w, false); f[12] = t.x; f[13] = t.y;
  t = __builtin_amdgcn_cvt_pk_f32_fp8((int)w.w, true); f[14] = t.x; f[15] = t.y;
}

__device__ __forceinline__ void phase_peer(const Params& p) {
  char* ws = p.ws;
  const unsigned char* PU = (const unsigned char*)(ws + OFF_PU);
  const unsigned char* PV = (const unsigned char*)(ws + OFF_PV);
  const u16* Hf = (const u16*)(ws + OFF_H);
  const float2* ROUTE = (const float2*)(ws + OFF_ROUTE);
  const int lane = threadIdx.x & 63;
  const int gw = blockIdx.x * 4 + (threadIdx.x >> 6), nw = gridDim.x * 4;
#pragma unroll 1
  for (int tk = gw; tk < NT; tk += nw) {
    float xf[16], o[16];
    unpack8(*(const uint4*)(Hf + (size_t)tk * HLD + lane * 16), xf);
    unpack8(*(const uint4*)(Hf + (size_t)tk * HLD + lane * 16 + 8), xf + 8);
#pragma unroll
    for (int j = 0; j < 16; j++) o[j] = 0.f;
    const float2* rt = ROUTE + (size_t)tk * 128;
    float2 rA[4], rB[4];
    uint4 uA[4], vA[4], uB[4], vB[4];
#define PLOAD(R, U, V, E)                                                        \
  _Pragma("unroll") for (int q = 0; q < 4; q++) {                                \
    R[q] = rt[(E) + q];                                                          \
    const size_t off = (size_t)__float_as_int(R[q].y) * 2048 + lane * 16;        \
    U[q] = *(const uint4*)(PU + off);                                            \
    V[q] = *(const uint4*)(PU + off + 1024);                                     \
  }
#define PCOMP(R, U, V)                                                           \
  _Pragma("unroll") for (int q = 0; q < 4; q++) {                                \
    float uf[16];                                                                \
    unpack_fp8x16(U[q], uf);                                                     \
    float d = 0.f;                                                               \
    _Pragma("unroll") for (int j = 0; j < 16; j++) d += uf[j] * xf[j];           \
    d = wave_sum(d) * (1.f / 64.f);                                              \
    const float act = 0.5f * d * (1.f + erff(d * 0.70710678118654752f));         \
    const float cf = R[q].x * act * (1.f / 16.f);                                \
    float vf[16];                                                                \
    unpack_fp8x16(V[q], vf);                                                     \
    _Pragma("unroll") for (int j = 0; j < 16; j++) o[j] += cf * vf[j];           \
  }
    PLOAD(rA, uA, vA, 0)
#pragma unroll 1
    for (int e = 0; e < 128; e += 8) {
      PLOAD(rB, uB, vB, e + 4)
      PCOMP(rA, uA, vA)
      if (e + 8 < 128) { PLOAD(rA, uA, vA, e + 8) }
      PCOMP(rB, uB, vB)
    }
#undef PLOAD
#undef PCOMP
    float* yr = p.out + (size_t)tk * 1024 + lane * 16;
    float4 x0 = *(const float4*)(yr), x1 = *(const float4*)(yr + 4), x2 = *(const float4*)(yr + 8), x3 = *(const float4*)(yr + 12);
    o[0] += x0.x; o[1] += x0.y; o[2] += x0.z; o[3] += x0.w; o[4] += x1.x; o[5] += x1.y; o[6] += x1.z; o[7] += x1.w;
    o[8] += x2.x; o[9] += x2.y; o[10] += x2.z; o[11] += x2.w; o[12] += x3.x; o[13] += x3.y; o[14] += x3.z; o[15] += x3.w;
    float ss = 0.f;
#pragma unroll
    for (int j = 0; j < 16; j++) ss += o[j] * o[j];
    ss = wave_sum(ss);
    const float rr = rsqrtf(ss * (1.f / 1024.f) + 1e-6f);
    const float* gf = p.g_final + lane * 16;
    float4 g0 = *(const float4*)(gf), g1 = *(const float4*)(gf + 4), g2 = *(const float4*)(gf + 8), g3 = *(const float4*)(gf + 12);
    *(float4*)(yr) = make_float4(o[0] * rr * g0.x, o[1] * rr * g0.y, o[2] * rr * g0.z, o[3] * rr * g0.w);
    *(float4*)(yr + 4) = make_float4(o[4] * rr * g1.x, o[5] * rr * g1.y, o[6] * rr * g1.z, o[7] * rr * g1.w);
    *(float4*)(yr + 8) = make_float4(o[8] * rr * g2.x, o[9] * rr * g2.y, o[10] * rr * g2.z, o[11] * rr * g2.w);
    *(float4*)(yr + 12) = make_float4(o[12] * rr * g3.x, o[13] * rr * g3.y, o[14] * rr * g3.z, o[15] * rr * g3.w);
  }
}

#define XB_TMO      128
#define XB_XCNT(j)  (256  + 64 * (j))
#define XB_XSUB(j)  (1280 + 64 * (j))
#define XB_XGEN(j)  (2304 + 64 * (j))
#define XB_TOP      3328
#define XB_TOPGEN   3392
#define XCD_BAR_WORDS 3456
#define XB_SPIN_CAP (1u << 18)
#define LAS __attribute__((address_space(3)))
__device__ __forceinline__ unsigned xb_ld(unsigned* p) { return __hip_atomic_load(p, __ATOMIC_RELAXED, __HIP_MEMORY_SCOPE_AGENT); }
__device__ __forceinline__ unsigned xb_add(unsigned* p, unsigned v) { return __hip_atomic_fetch_add(p, v, __ATOMIC_RELAXED, __HIP_MEMORY_SCOPE_AGENT); }
__device__ __forceinline__ unsigned xb_xcc_id() { return (unsigned)__builtin_amdgcn_s_getreg((3 << 11) | 20) & 0xFu; }
#define XB_SPIN(cond, bar) do { unsigned _sp = 0; while (cond) { __builtin_amdgcn_s_sleep(1); \
    if ((++_sp & 255u) == 0u) { if (xb_ld(&(bar)[XB_TMO])) break; if (_sp > XB_SPIN_CAP) { atomicAdd(&(bar)[XB_TMO], 1u); break; } } } } while (0)
struct XcdBarrier { unsigned* bar; unsigned x; volatile LAS unsigned* st; };
__device__ __forceinline__ XcdBarrier xcd_barrier_post(unsigned* bar, volatile LAS unsigned* st) {
  XcdBarrier b; b.bar = bar; b.x = xb_xcc_id(); b.st = st;
  if (threadIdx.x == 0) (void)xb_add(&bar[XB_XCNT(b.x)], 1u);
  return b;
}
__device__ __forceinline__ void xcd_barrier_complete(unsigned* bar, unsigned x, unsigned& nloc, unsigned& nx) {
  const unsigned G = gridDim.x * gridDim.y * gridDim.z;
  unsigned sum, cnt, mine, sp = 0u;
  for (;;) {
    sum = 0u; cnt = 0u; mine = 0u;
#pragma unroll
    for (unsigned j = 0; j < 16; ++j) { const unsigned c = xb_ld(&bar[XB_XCNT(j)]); sum += c; cnt += (c > 0u) ? 1u : 0u; mine = (j == x) ? c : mine; }
    if (sum == G) break;
    __builtin_amdgcn_s_sleep(1);
    if ((++sp & 255u) == 0u) { if (xb_ld(&bar[XB_TMO])) break; if (sp > XB_SPIN_CAP) { atomicAdd(&bar[XB_TMO], 1u); break; } }
  }
  nloc = mine > 0u ? mine : 1u; nx = cnt > 0u ? cnt : 1u;
}
__device__ __forceinline__ void xcd_barrier(unsigned* bbar, unsigned bx, volatile LAS unsigned* bst) {
  asm volatile("s_waitcnt vmcnt(0)" ::: "memory");
  __syncthreads();
  if (threadIdx.x == 0) {
    unsigned* bar = bbar;
    __builtin_amdgcn_s_waitcnt(0);
    unsigned nloc = bst[0], nx = bst[1];
    if (nloc == 0u) { xcd_barrier_complete(bar, bx, nloc, nx); bst[0] = nloc; bst[1] = nx; }
    const unsigned old = xb_add(&bar[XB_XSUB(bx)], 1u);
    const unsigned gen = old / nloc;
    if (old + 1u == (gen + 1u) * nloc) {
      __builtin_amdgcn_fence(__ATOMIC_RELEASE, "agent");
      asm volatile("s_waitcnt vmcnt(0)" ::: "memory");
      const unsigned og = xb_add(&bar[XB_TOP], 1u);
      const unsigned tg = og / nx;
      if (og + 1u == (tg + 1u) * nx) xb_add(&bar[XB_TOPGEN], 1u);
      else XB_SPIN(xb_ld(&bar[XB_TOPGEN]) == tg, bar);
      __builtin_amdgcn_fence(__ATOMIC_ACQUIRE, "agent");
      xb_add(&bar[XB_XGEN(bx)], 1u);
      asm volatile("s_waitcnt vmcnt(0)" ::: "memory");
    } else {
      XB_SPIN(xb_ld(&bar[XB_XGEN(bx)]) == gen, bar);
      __builtin_amdgcn_fence(__ATOMIC_ACQUIRE, "agent");
      asm volatile("s_waitcnt vmcnt(0)" ::: "memory");
    }
  }
  __syncthreads();
}

__global__ void __launch_bounds__(256, 2) fwd_kernel(Params pk) {
  __shared__ __attribute__((aligned(16))) char smem[SMEM_BYTES];
  __shared__ int s_item;
  __shared__ uint4 xb_words;
  if (threadIdx.x == 0) xb_words = make_uint4(0u, 0u, 0u, 0u);
  __syncthreads();
  unsigned* const xb_bar = (unsigned*)(pk.ws + OFF_BAR);
  volatile LAS unsigned* const xb_st = (volatile LAS unsigned*)&xb_words;
  const unsigned xb_x = xb_xcc_id();
  if (threadIdx.x == 0) (void)xb_add(&xb_bar[XB_XCNT(xb_x)], 1u);
#ifdef ONLY_PHASE
#define RUN(PH, ...) if (PH == ONLY_PHASE) { const Params& p = pk; char* ws = p.ws; (void)ws; __VA_ARGS__; }
#else
typedef const Params __attribute__((address_space(4))) * KParamsPtr;
#if defined(__HIP_DEVICE_COMPILE__)
#define LOAD_PARAMS                                                                   \
  KParamsPtr kp_ = (KParamsPtr)__builtin_amdgcn_kernarg_segment_ptr();                \
  asm volatile("" : "+s"(kp_));                                                       \
  const Params p = *kp_;
#else
#define LOAD_PARAMS const Params p = pk;
#endif
#define RUN(PH, ...)                                   \
  if (pk.ph0 <= PH && PH < pk.ph1) {                   \
    {                                                  \
      LOAD_PARAMS                                      \
      char* ws = p.ws;                                 \
      (void)ws;                                        \
      __VA_ARGS__;                                     \
    }                                                  \
    if (PH + 1 < pk.ph1) xcd_barrier(xb_bar, xb_x, xb_st); \
  }
#endif
  RUN(0, phase_prep(p, smem))
  RUN(1, phase_gemm_in(p, smem); prep_jobs(p, smem, 1440, 1952))
  RUN(2, phase_conv(p))
  RUN(3, phase_mixers(p, smem, &s_item))
  RUN(4, mlstm_scan(p))
  RUN(5, phase_mlstm_out(p, smem))
  RUN(6, phase_mixed(p, smem))
  RUN(7, phase_gemm_generic(p, smem, (const u16*)(ws + OFF_H), (const u16*)(ws + OFF_WT_OUT), 8, 0, nullptr, 0); prep_jobs(p, smem, 2464, 3488))
  RUN(8, phase_norm(p, p.g_cross))
  RUN(9, phase_gemm_generic(p, smem, (const u16*)(ws + OFF_H), (const u16*)(ws + OFF_WT_CQ), 8, 2, (u16*)(ws + OFF_QC), HLD); prep_jobs(p, smem, 4512, 5536); prep_memk(p))
  RUN(10, phase_cross(p, smem))
  RUN(11, phase_gemm_generic(p, smem, (const u16*)(ws + OFF_QC), (const u16*)(ws + OFF_WT_CO), 8, 1, nullptr, 0))
  RUN(12, phase_norm(p, p.g_ffn))
  RUN(13, phase_gemm_generic(p, smem, (const u16*)(ws + OFF_H), (const u16*)(ws + OFF_WT_PQ), 16, 2, (u16*)(ws + OFF_PQ), PQLD))
  RUN(14, phase_route(p, smem))
  RUN(15, phase_peer(p))
  if (pk.ph0 < 0) cg::this_grid().sync();
}

extern "C" void kernel_launch(void* const* d_in, const int* in_sizes, int n_in, void* d_out, int out_size, void* d_ws,
                              size_t ws_size, hipStream_t stream) {
  static int grid_blocks = 0;
  static int cus = 0;
  if (!cus) {
    int dev = 0;
    (void)hipGetDevice(&dev);
    (void)hipDeviceGetAttribute(&cus, hipDeviceAttributeMultiprocessorCount, dev);
    if (cus <= 0) cus = 256;
  }
  Params p;
  memset(&p, 0, sizeof(p));
  const float** f = (const float**)&p;
  for (int i = 0; i < 33; i++) f[i] = (const float*)d_in[i];
  p.out = (float*)d_out;
  p.ws = (char*)d_ws;
#if COOP
  p.ph0 = 0; p.ph1 = NPHASE;
  void* args[] = {&p};
  (void)hipMemsetAsync((char*)d_ws + OFF_BAR, 0, XCD_BAR_WORDS * 4, stream);
  if (!grid_blocks) {
    hipError_t e = hipLaunchCooperativeKernel((void*)fwd_kernel, dim3(2 * cus), dim3(256), args, 0, stream);
    if (e == hipSuccess) { grid_blocks = 2 * cus; return; }
    (void)hipGetLastError();
    grid_blocks = cus;
  }
  hipError_t e = hipLaunchCooperativeKernel((void*)fwd_kernel, dim3(grid_blocks), dim3(256), args, 0, stream);
  if (e != hipSuccess) fprintf(stderr, "cooperative launch failed: %s (grid %d)\n", hipGetErrorString(e), grid_blocks);
#else
  for (int ph = 0; ph < NPHASE; ph++) {
    p.ph0 = ph; p.ph1 = ph + 1;
    hipLaunchKernelGGL(fwd_kernel, dim3(2 * cus), dim3(256), 0, stream, p);
  }
#endif
}
```
